# Optimizing an MI355X kernel written in HIP

```python
import numpy as np
import jax, jax.numpy as jnp
from jax import lax

D_MODEL = 1024
BATCH = 16
SEQ = 4096
DEPTH = 4

CTX_LEN = 256
GRID_W = 64
D_MIX = D_MODEL
HEAD_DIM = 64
ATTN_HEADS = D_MIX // 2 // HEAD_DIM
ATTN_KV_HEADS = ATTN_HEADS // 4
ATTN_GROUP = ATTN_HEADS // ATTN_KV_HEADS
WINDOW = 128
ATTN_BLOCK = 128
ROPE_BASE = 10000.0
ROPE_AXIS_DIM = HEAD_DIM // 2
M_HEADS = D_MIX // 4 // HEAD_DIM
M_WIDTH = M_HEADS * HEAD_DIM
M_CHUNK = 64
G_HEADS = D_MIX // 4 // HEAD_DIM
G_WIDTH = G_HEADS * HEAD_DIM
G_CHUNK = 64
GLA_RANK = 16
GLA_TAU = 16.0
D_FF = 4 * D_MODEL
EPS = 1e-6
IN_SPLITS = (ATTN_HEADS * HEAD_DIM, ATTN_KV_HEADS * HEAD_DIM, ATTN_KV_HEADS * HEAD_DIM,
             M_WIDTH, M_WIDTH, M_WIDTH, M_WIDTH, 2 * M_HEADS, 2 * M_HEADS,
             G_WIDTH, G_WIDTH, G_WIDTH, G_WIDTH, 2 * GLA_RANK)
IN_COLS = sum(IN_SPLITS)

kernel_name = 'hymba_style_flow_backbone'

F32 = jnp.float32


def rmsnorm(x, g):
    xf = x.astype(F32)
    xf = xf * lax.rsqrt(jnp.mean(xf * xf, axis=-1, keepdims=True) + EPS)
    return (xf * g.astype(F32)).astype(x.dtype)


def head_rmsnorm(x, g, n_heads):
    B, N, _ = x.shape
    xh = x.reshape(B, N, n_heads, HEAD_DIM).astype(F32)
    xh = xh * lax.rsqrt(jnp.mean(xh * xh, axis=-1, keepdims=True) + EPS)
    return (xh.reshape(B, N, n_heads * HEAD_DIM) * g.astype(F32)).astype(x.dtype)


def modulate(h, shift, scale):
    return h * (1.0 + scale) + shift


def squared_relu_mlp(h, w1, w2):
    return jnp.square(jax.nn.relu(h @ w1)) @ w2


def split_cols(p):
    idx = np.cumsum(IN_SPLITS)[:-1].tolist()
    return jnp.split(p, idx, axis=-1)


def to_heads(t, n_heads):
    B, N, _ = t.shape
    return t.reshape(B, N, n_heads, HEAD_DIM).transpose(0, 2, 1, 3)


def from_heads(t):
    B, H, N, D = t.shape
    return t.transpose(0, 2, 1, 3).reshape(B, N, H * D)


def axial_rope_tables(rows):
    t_row = jnp.repeat(jnp.arange(rows), GRID_W).astype(F32)
    t_col = jnp.tile(jnp.arange(GRID_W), rows).astype(F32)
    inv = ROPE_BASE ** (-jnp.arange(0, ROPE_AXIS_DIM, 2, dtype=F32) / ROPE_AXIS_DIM)
    ang_r = t_row[:, None] * inv[None, :]
    ang_c = t_col[:, None] * inv[None, :]
    return (jnp.cos(ang_r), jnp.sin(ang_r), jnp.cos(ang_c), jnp.sin(ang_c))


def rotate_axis(xa, cos, sin):
    half = xa.shape[-1] // 2
    x1, x2 = xa[..., :half], xa[..., half:]
    cos = cos[None, :, None, :].astype(xa.dtype)
    sin = sin[None, :, None, :].astype(xa.dtype)
    return jnp.concatenate([x1 * cos - x2 * sin, x2 * cos + x1 * sin], axis=-1)


def apply_axial_rope(x, rope):
    cos_r, sin_r, cos_c, sin_c = rope
    return jnp.concatenate([rotate_axis(x[..., :ROPE_AXIS_DIM], cos_r, sin_r),
                            rotate_axis(x[..., ROPE_AXIS_DIM:], cos_c, sin_c)], axis=-1)


def sink_softmax(s, sink):
    sk = sink.astype(F32)[None, :, :, None, None]
    m = jnp.maximum(jnp.max(s, axis=-1, keepdims=True), sk)
    e = jnp.exp(s - m)
    return e / (jnp.sum(e, axis=-1, keepdims=True) + jnp.exp(sk - m))


def context_attention(q, k, v, sink):
    B, Nc = q.shape[:2]
    s = jnp.einsum('bqhgd,bkhd->bhgqk', q, k).astype(F32)
    p = sink_softmax(s, sink).astype(v.dtype)
    return jnp.einsum('bhgqk,bkhd->bqhgd', p, v).reshape(B, Nc, -1)


def window_attention(q, k, v, kc, vc, sink):
    B, N, KV, G, D = q.shape
    nb = N // ATTN_BLOCK
    pad = ((0, 0), (ATTN_BLOCK, ATTN_BLOCK), (0, 0), (0, 0))
    kp = jnp.pad(k, pad)
    vp = jnp.pad(v, pad)
    qb = q.reshape(B, nb, ATTN_BLOCK, KV, G, D).transpose(1, 0, 2, 3, 4, 5)
    q_offs = jnp.arange(ATTN_BLOCK)
    k_offs = jnp.arange(3 * ATTN_BLOCK)

    def block(args):
        j, qj = args
        kj = lax.dynamic_slice_in_dim(kp, j * ATTN_BLOCK, 3 * ATTN_BLOCK, axis=1)
        vj = lax.dynamic_slice_in_dim(vp, j * ATTN_BLOCK, 3 * ATTN_BLOCK, axis=1)
        qpos = j * ATTN_BLOCK + q_offs
        kpos = (j - 1) * ATTN_BLOCK + k_offs
        valid = ((jnp.abs(qpos[:, None] - kpos[None, :]) <= WINDOW)
                 & (kpos >= 0)[None, :] & (kpos < N)[None, :])
        s_loc = jnp.einsum('bqhgd,bkhd->bhgqk', qj, kj).astype(F32)
        s_loc = jnp.where(valid, s_loc, -jnp.inf)
        s_ctx = jnp.einsum('bqhgd,bkhd->bhgqk', qj, kc).astype(F32)
        p = sink_softmax(jnp.concatenate([s_loc, s_ctx], axis=-1), sink).astype(v.dtype)
        return (jnp.einsum('bhgqk,bkhd->bqhgd', p[..., :3 * ATTN_BLOCK], vj)
                + jnp.einsum('bhgqk,bkhd->bqhgd', p[..., 3 * ATTN_BLOCK:], vc))

    o = lax.map(block, (jnp.arange(nb), qb))
    return o.transpose(1, 0, 2, 3, 4, 5).reshape(B, N, KV * G * D)


def mlstm_chunked(q, k, v, logi, logf, state, with_h):
    dt = v.dtype
    B, H, N, D = q.shape
    nc = N // M_CHUNK
    q = q.astype(F32).reshape(B, H, nc, M_CHUNK, D)
    k = (k.astype(F32) * D ** -0.5).reshape(B, H, nc, M_CHUNK, D)
    v = v.astype(F32).reshape(B, H, nc, M_CHUNK, D)
    logi = logi.astype(F32).reshape(B, H, nc, M_CHUNK)
    b = jnp.cumsum(logf.astype(F32).reshape(B, H, nc, M_CHUNK), axis=-1)
    a = b[..., -1]
    g = a[..., None] - b + logi
    m_chunk = jnp.max(g, axis=-1)
    w = jnp.exp(g - m_chunk[..., None])
    c_chunk = jnp.einsum('bhcs,bhcsd,bhcse->bhcde', w, v, k)
    n_chunk = jnp.einsum('bhcs,bhcse->bhce', w, k)
    if state is None:
        state = (jnp.zeros((B, H, D, D), F32), jnp.zeros((B, H, D), F32), jnp.zeros((B, H), F32))

    def step(carry, inp):
        C, n, m = carry
        a_i, m_i, c_i, n_i = inp
        m_new = jnp.maximum(a_i + m, m_i)
        s_old = jnp.exp(a_i + m - m_new)
        s_new = jnp.exp(m_i - m_new)
        C_new = s_old[..., None, None] * C + s_new[..., None, None] * c_i
        n_new = s_old[..., None] * n + s_new[..., None] * n_i
        return (C_new, n_new, m_new), (C, n, m)

    xs = tuple(jnp.moveaxis(t, 2, 0) for t in (a, m_chunk, c_chunk, n_chunk))
    final, prev = lax.scan(step, state, xs)
    if not with_h:
        return None, final
    c_prev, n_prev, m_prev = (jnp.moveaxis(t, 0, 2) for t in prev)
    lower = jnp.tril(jnp.ones((M_CHUNK, M_CHUNK), bool))
    dmat = jnp.where(lower, b[..., :, None] - b[..., None, :] + logi[..., None, :], -jnp.inf)
    inter = b + m_prev[..., None]
    m_r = jnp.maximum(inter, jnp.max(dmat, axis=-1))
    p = jnp.exp(dmat - m_r[..., None]) * jnp.einsum('bhcrd,bhcsd->bhcrs', q, k)
    w_inter = jnp.exp(inter - m_r)
    num = (w_inter[..., None] * jnp.einsum('bhcde,bhcre->bhcrd', c_prev, q)
           + jnp.einsum('bhcrs,bhcsd->bhcrd', p, v))
    den = w_inter * jnp.einsum('bhce,bhcre->bhcr', n_prev, q) + jnp.sum(p, axis=-1)
    h = num / jnp.maximum(jnp.abs(den), jnp.exp(-m_r))[..., None]
    return h.reshape(B, H, N, D).astype(dt), final


def gla_chunked(q, k, v, glog, state, with_h):
    dt = v.dtype
    B, H, N, D = q.shape
    nc = N // G_CHUNK
    q = (q.astype(F32) * D ** -0.5).reshape(B, H, nc, G_CHUNK, D)
    k = k.astype(F32).reshape(B, H, nc, G_CHUNK, D)
    v = v.astype(F32).reshape(B, H, nc, G_CHUNK, D)
    bc = jnp.cumsum(glog.astype(F32).reshape(B, H, nc, G_CHUNK, D), axis=3)
    b_end = bc[:, :, :, -1:, :]
    u = jnp.einsum('bhcsk,bhcsv->bhckv', k * jnp.exp(b_end - bc), v)
    decay = jnp.exp(b_end[:, :, :, 0, :])
    if state is None:
        state = jnp.zeros((B, H, D, D), F32)

    def step(S, inp):
        d_i, u_i = inp
        return d_i[..., None] * S + u_i, S

    final, s_prev = lax.scan(step, state, (jnp.moveaxis(decay, 2, 0), jnp.moveaxis(u, 2, 0)))
    if not with_h:
        return None, final
    s_prev = jnp.moveaxis(s_prev, 0, 2)
    qd = q * jnp.exp(bc)
    kd = k * jnp.exp(-bc)
    lower = jnp.tril(jnp.ones((G_CHUNK, G_CHUNK), bool))
    att = jnp.where(lower, jnp.einsum('bhcrk,bhcsk->bhcrs', qd, kd), 0.0)
    o = jnp.einsum('bhcrs,bhcsv->bhcrv', att, v) + jnp.einsum('bhcrk,bhckv->bhcrv', qd, s_prev)
    return o.reshape(B, H, N, D).astype(dt), final


def run_direction(scan_fn, ctx_args, lat_args, flip, with_ctx_out):
    if flip:
        ctx_args = tuple(jnp.flip(t, axis=2) for t in ctx_args)
        lat_args = tuple(jnp.flip(t, axis=2) for t in lat_args)
    h_ctx, ctx_state = scan_fn(*ctx_args, None, with_ctx_out)
    h_lat, _ = scan_fn(*lat_args, ctx_state, True)
    if flip:
        h_lat = jnp.flip(h_lat, axis=2)
        if h_ctx is not None:
            h_ctx = jnp.flip(h_ctx, axis=2)
    return h_ctx, h_lat


def mixer_inputs(p, m_i_bias, m_f_bias, g_wa2, g_ba):
    aq, ak, av, mq, mk, mv, mo, mi, mf, gq, gk, gv, gg, glr = split_cols(p)
    B, N, _ = p.shape
    attn = (aq.reshape(B, N, ATTN_HEADS, HEAD_DIM),
            ak.reshape(B, N, ATTN_KV_HEADS, HEAD_DIM),
            av.reshape(B, N, ATTN_KV_HEADS, HEAD_DIM))
    logi = (mi.reshape(B, N, 2, M_HEADS).astype(F32) + m_i_bias.astype(F32)).transpose(2, 0, 3, 1)
    logf = jax.nn.log_sigmoid(mf.reshape(B, N, 2, M_HEADS).astype(F32)
                              + m_f_bias.astype(F32)).transpose(2, 0, 3, 1)
    mlstm = (to_heads(mq, M_HEADS), to_heads(mk, M_HEADS), to_heads(mv, M_HEADS), logi, logf)
    glog = jax.nn.log_sigmoid(jnp.einsum('bnjr,jrw->jbnw', glr.reshape(B, N, 2, GLA_RANK).astype(F32),
                                         g_wa2.astype(F32))
                              + g_ba.astype(F32)[:, None, None, :]) / GLA_TAU
    glog = glog.reshape(2, B, N, G_HEADS, HEAD_DIM).transpose(0, 1, 3, 2, 4)
    gla = (to_heads(gq, G_HEADS), to_heads(gk, G_HEADS), to_heads(gv, G_HEADS), glog)
    return attn, mlstm, jax.nn.sigmoid(mo), gla, jax.nn.silu(gg)


def token_mixer(h, hc, rope, w_in, sink, m_i_bias, m_f_bias, m_norm_g, g_wa2, g_ba, g_norm_g, w_out,
                with_ctx_out):
    B, N, _ = h.shape
    Nc = hc.shape[1]
    (aq, ak, av), (mq, mk, mv, mi, mf), m_o, (gq, gk, gv, gl), g_gate = mixer_inputs(
        h @ w_in, m_i_bias, m_f_bias, g_wa2, g_ba)
    (aqc, akc, avc), (mqc, mkc, mvc, mic, mfc), m_oc, (gqc, gkc, gvc, glc), g_gatec = mixer_inputs(
        hc @ w_in, m_i_bias, m_f_bias, g_wa2, g_ba)
    sink_g = sink.reshape(ATTN_KV_HEADS, ATTN_GROUP)
    q = (apply_axial_rope(aq, rope) * HEAD_DIM ** -0.5).reshape(B, N, ATTN_KV_HEADS, ATTN_GROUP, HEAD_DIM)
    k = apply_axial_rope(ak, rope)
    out_a = window_attention(q, k, av, akc, avc, sink_g)
    hm = [run_direction(mlstm_chunked, (mqc, mkc, mvc, mic[d], mfc[d]), (mq, mk, mv, mi[d], mf[d]),
                        flip, with_ctx_out) for d, flip in ((0, False), (1, True))]
    out_m = head_rmsnorm(from_heads(hm[0][1] + hm[1][1]), m_norm_g, M_HEADS) * m_o
    hg = [run_direction(gla_chunked, (gqc, gkc, gvc, glc[d]), (gq, gk, gv, gl[d]),
                        flip, with_ctx_out) for d, flip in ((0, False), (1, True))]
    out_g = head_rmsnorm(from_heads(hg[0][1] + hg[1][1]), g_norm_g, G_HEADS) * g_gate
    o = jnp.concatenate([out_a, out_m, out_g], axis=-1) @ w_out
    if not with_ctx_out:
        return o, None
    qc = (aqc * HEAD_DIM ** -0.5).reshape(B, Nc, ATTN_KV_HEADS, ATTN_GROUP, HEAD_DIM)
    out_ac = context_attention(qc, akc, avc, sink_g)
    out_mc = head_rmsnorm(from_heads(hm[0][0] + hm[1][0]), m_norm_g, M_HEADS) * m_oc
    out_gc = head_rmsnorm(from_heads(hg[0][0] + hg[1][0]), g_norm_g, G_HEADS) * g_gatec
    oc = jnp.concatenate([out_ac, out_mc, out_gc], axis=-1) @ w_out
    return o, oc


def setup_inputs(seed: int = 0) -> dict:
    key = jax.random.key(seed)
    ks = jax.random.split(key, 20)

    def nrm(k, shape, scale):
        return jax.random.normal(k, shape, F32) * scale

    return {
        'x': nrm(ks[0], (BATCH, SEQ, D_MODEL), 1.0),
        'c': nrm(ks[1], (BATCH, D_MODEL), 1.0),
        'ctx': nrm(ks[2], (BATCH, CTX_LEN, D_MODEL), 1.0),
        'c_ctx': nrm(ks[3], (D_MODEL,), 1.0),
        'w_ada': nrm(ks[4], (DEPTH, D_MODEL, 6 * D_MODEL), 0.5 * D_MODEL ** -0.5),
        'b_ada': nrm(ks[5], (DEPTH, 6 * D_MODEL), 0.02),
        'norm1_g': 1.0 + nrm(ks[6], (DEPTH, D_MODEL), 0.05),
        'norm2_g': 1.0 + nrm(ks[7], (DEPTH, D_MODEL), 0.05),
        'w_in': nrm(ks[8], (DEPTH, D_MODEL, IN_COLS), D_MODEL ** -0.5),
        'attn_sink': nrm(ks[9], (DEPTH, ATTN_HEADS), 0.5),
        'm_i_bias': nrm(ks[10], (DEPTH, 2, M_HEADS), 0.1),
        'm_f_bias': 3.0 + 3.0 * jax.random.uniform(ks[11], (DEPTH, 2, M_HEADS), F32),
        'm_norm_g': 1.0 + nrm(ks[12], (DEPTH, M_WIDTH), 0.05),
        'g_wa2': nrm(ks[13], (DEPTH, 2, GLA_RANK, G_WIDTH), GLA_RANK ** -0.5),
        'g_ba': nrm(ks[14], (DEPTH, 2, G_WIDTH), 0.1),
        'g_norm_g': 1.0 + nrm(ks[15], (DEPTH, G_WIDTH), 0.05),
        'w_out': nrm(ks[16], (DEPTH, D_MIX, D_MODEL), D_MIX ** -0.5),
        'w_mlp1': nrm(ks[17], (DEPTH, D_MODEL, D_FF), D_MODEL ** -0.5),
        'w_mlp2': nrm(ks[18], (DEPTH, D_FF, D_MODEL), D_FF ** -0.5),
        'final_g': 1.0 + nrm(ks[19], (D_MODEL,), 0.05),
    }


def reference(x, c, ctx, c_ctx, w_ada, b_ada, norm1_g, norm2_g, w_in, attn_sink, m_i_bias, m_f_bias,
              m_norm_g, g_wa2, g_ba, g_norm_g, w_out, w_mlp1, w_mlp2, final_g):
    B, N, D = x.shape
    ROWS = N // GRID_W
    rope = axial_rope_tables(ROWS)
    sc = jax.nn.silu(c)
    sctx = jax.nn.silu(c_ctx)
    xc = ctx
    for l in range(DEPTH):
        last = l == DEPTH - 1
        mx = (sc @ w_ada[l] + b_ada[l]).reshape(B, 6, 1, D)
        mc = (sctx @ w_ada[l] + b_ada[l]).reshape(6, D)
        h = modulate(rmsnorm(x, norm1_g[l]), mx[:, 0], mx[:, 1])
        hc = modulate(rmsnorm(xc, norm1_g[l]), mc[0], mc[1])
        o, oc = token_mixer(h, hc, rope, w_in[l], attn_sink[l], m_i_bias[l], m_f_bias[l], m_norm_g[l],
                            g_wa2[l], g_ba[l], g_norm_g[l], w_out[l], not last)
        x = x + mx[:, 2] * o
        x = x + mx[:, 5] * squared_relu_mlp(modulate(rmsnorm(x, norm2_g[l]), mx[:, 3], mx[:, 4]),
                                            w_mlp1[l], w_mlp2[l])
        if not last:
            xc = xc + mc[2] * oc
            xc = xc + mc[5] * squared_relu_mlp(modulate(rmsnorm(xc, norm2_g[l]), mc[3], mc[4]),
                                               w_mlp1[l], w_mlp2[l])
    return rmsnorm(x, final_g)
```

```cpp
#include <hip/hip_runtime.h>
#include <hip/hip_cooperative_groups.h>
#include <cstdio>
#include <cstdint>
namespace cg = cooperative_groups;
__device__ const float ROPE_C[1024] = {1.000000000e+00f,1.000000000e+00f,1.000000000e+00f,1.000000000e+00f,1.000000000e+00f,1.000000000e+00f,1.000000000e+00f,1.000000000e+00f,1.000000000e+00f,1.000000000e+00f,1.000000000e+00f,1.000000000e+00f,1.000000000e+00f,1.000000000e+00f,1.000000000e+00f,1.000000000e+00f,5.403022766e-01f,8.460091352e-01f,9.504152536e-01f,9.842302203e-01f,9.950041771e-01f,9.984192848e-01f,9.995000362e-01f,9.998418689e-01f,9.999499917e-01f,9.999842048e-01f,9.999949932e-01f,9.999983907e-01f,9.999995232e-01f,9.999998212e-01f,9.999999404e-01f,1.000000000e+00f,-4.161468446e-01f,4.314628243e-01f,8.065783978e-01f,9.374182820e-01f,9.800665975e-01f,9.936820865e-01f,9.980006814e-01f,9.993675947e-01f,9.998000264e-01f,9.999367595e-01f,9.999799728e-01f,9.999936819e-01f,9.999979734e-01f,9.999993443e-01f,9.999998212e-01f,9.999999404e-01f,-9.899924994e-01f,-1.159661636e-01f,5.827535987e-01f,8.610406518e-01f,9.553365111e-01f,9.858034849e-01f,9.955033660e-01f,9.985772967e-01f,9.995500445e-01f,9.998577237e-01f,9.999549985e-01f,9.999857545e-01f,9.999955297e-01f,9.999985695e-01f,9.999995232e-01f,9.999998808e-01f,-6.536436081e-01f,-6.276797056e-01f,3.011374772e-01f,7.575061917e-01f,9.210609794e-01f,9.748082757e-01f,9.920106530e-01f,9.974712729e-01f,9.992001057e-01f,9.997470379e-01f,9.999200106e-01f,9.999747276e-01f,9.999920130e-01f,9.999974966e-01f,9.999992251e-01f,9.999997616e-01f,2.836622000e-01f,-9.460792542e-01f,-1.034230832e-02f,6.300802827e-01f,8.775825500e-01f,9.607312679e-01f,9.875259995e-01f,9.960497618e-01f,9.987502694e-01f,9.996047616e-01f,9.998750091e-01f,9.999604821e-01f,9.999874830e-01f,9.999960661e-01f,9.999987483e-01f,9.999995828e-01f,9.601702690e-01f,-9.731037021e-01f,-3.207964599e-01f,4.827820063e-01f,8.253356218e-01f,9.436169863e-01f,9.820539355e-01f,9.943132997e-01f,9.982005358e-01f,9.994308352e-01f,9.998199940e-01f,9.999430776e-01f,9.999819994e-01f,9.999943376e-01f,9.999982119e-01f,9.999994040e-01f,7.539022565e-01f,-7.004299164e-01f,-5.994373560e-01f,3.202569783e-01f,7.648421526e-01f,9.235194325e-01f,9.755998850e-01f,9.922624230e-01f,9.975510240e-01f,9.992253184e-01f,9.997550249e-01f,9.999225140e-01f,9.999755025e-01f,9.999922514e-01f,9.999975562e-01f,9.999992251e-01f,-1.455000341e-01f,-2.120364457e-01f,-8.186324239e-01f,1.476312131e-01f,6.967067122e-01f,9.005023241e-01f,9.681702852e-01f,9.898977876e-01f,9.968017340e-01f,9.989882708e-01f,9.996800423e-01f,9.998987913e-01f,9.999679923e-01f,9.999898672e-01f,9.999967813e-01f,9.999989867e-01f,-9.111302495e-01f,3.416603804e-01f,-9.566441774e-01f,-2.965078130e-02f,6.216099858e-01f,8.746382594e-01f,9.597726464e-01f,9.872201085e-01f,9.959527254e-01f,9.987195730e-01f,9.995950460e-01f,9.998719096e-01f,9.999595284e-01f,9.999871850e-01f,9.999959469e-01f,9.999987483e-01f,-8.390715122e-01f,7.901319861e-01f,-9.997860789e-01f,-2.059976012e-01f,5.403022766e-01f,8.460091352e-01f,9.504153132e-01f,9.842302203e-01f,9.950041771e-01f,9.984192848e-01f,9.995000362e-01f,9.998418689e-01f,9.999499917e-01f,9.999842048e-01f,9.999949932e-01f,9.999983907e-01f,4.425697960e-03f,9.952573776e-01f,-9.437797070e-01f,-3.758473694e-01f,4.535961151e-01f,8.147053123e-01f,9.401075840e-01f,9.809291363e-01f,9.939560890e-01f,9.980874062e-01f,9.993950725e-01f,9.998086691e-01f,9.999395013e-01f,9.999808669e-01f,9.999939203e-01f,9.999980927e-01f,8.438539505e-01f,8.938615918e-01f,-7.941792607e-01f,-5.338430405e-01f,3.623577356e-01f,7.808259130e-01f,9.288598895e-01f,9.773178697e-01f,9.928086400e-01f,9.977239966e-01f,9.992800951e-01f,9.997723103e-01f,9.999279976e-01f,9.999772310e-01f,9.999927878e-01f,9.999977350e-01f,9.074468017e-01f,5.171727538e-01f,-5.658205152e-01f,-6.750016212e-01f,2.674988210e-01f,7.444779873e-01f,9.166833758e-01f,9.733975530e-01f,9.915618896e-01f,9.973290563e-01f,9.991551042e-01f,9.997327924e-01f,9.999154806e-01f,9.999732971e-01f,9.999915361e-01f,9.999973178e-01f,1.367372125e-01f,-1.879591309e-02f,-2.813496590e-01f,-7.948709130e-01f,1.699671149e-01f,7.057763934e-01f,9.035902619e-01f,9.691694379e-01f,9.902160168e-01f,9.969025850e-01f,9.990201592e-01f,9.996901155e-01f,9.999020100e-01f,9.999690056e-01f,9.999902248e-01f,9.999969006e-01f,-7.596879005e-01f,-5.489757657e-01f,3.102250025e-02f,-8.896703720e-01f,7.073718309e-02f,6.648435593e-01f,8.895936012e-01f,9.646348357e-01f,9.887710810e-01f,9.964445233e-01f,9.988752007e-01f,9.996442795e-01f,9.998875260e-01f,9.999644160e-01f,9.999887347e-01f,9.999964237e-01f,-9.576594830e-01f,-9.100810885e-01f,3.403181732e-01f,-9.564100504e-01f,-2.919954620e-02f,6.218088269e-01f,8.747074604e-01f,9.597951770e-01f,9.872272611e-01f,9.959549904e-01f,9.987202883e-01f,9.995952845e-01f,9.998720288e-01f,9.999595284e-01f,9.999871850e-01f,9.999959469e-01f,-2.751633525e-01f,-9.908980131e-01f,6.158646941e-01f,-9.929850101e-01f,-1.288445145e-01f,5.768082738e-01f,8.589466810e-01f,9.546520114e-01f,9.855847955e-01f,9.954339862e-01f,9.985553622e-01f,9.995430708e-01f,9.998555183e-01f,9.999542832e-01f,9.999855757e-01f,9.999954104e-01f,6.603167057e-01f,-7.665364146e-01f,8.303362131e-01f,-9.982416630e-01f,-2.272021174e-01f,5.299842358e-01f,8.423270583e-01f,9.492070079e-01f,9.838436842e-01f,9.948815107e-01f,9.983804226e-01f,9.994877577e-01f,9.998379946e-01f,9.999487996e-01f,9.999837875e-01f,9.999948740e-01f,9.887046218e-01f,-3.060955107e-01f,9.624637961e-01f,-9.720142484e-01f,-3.232896030e-01f,4.814846218e-01f,8.248651624e-01f,9.434618354e-01f,9.820042253e-01f,9.942975044e-01f,9.981955290e-01f,9.994292855e-01f,9.998195171e-01f,9.999428988e-01f,9.999819398e-01f,9.999942780e-01f,4.080820680e-01f,2.486171871e-01f,9.991443753e-01f,-9.151299596e-01f,-4.161468744e-01f,4.314628243e-01f,8.065784574e-01f,9.374182820e-01f,9.800665975e-01f,9.936820865e-01f,9.980006814e-01f,9.993675947e-01f,9.998000264e-01f,9.999367595e-01f,9.999799728e-01f,9.999936819e-01f,-5.477292538e-01f,7.267603278e-01f,9.367403984e-01f,-8.293828964e-01f,-5.048461556e-01f,3.800770044e-01f,7.874851823e-01f,9.310783744e-01f,9.780309200e-01f,9.930352569e-01f,9.977958202e-01f,9.993028045e-01f,9.997795224e-01f,9.999302626e-01f,9.999779463e-01f,9.999930263e-01f,-9.999608397e-01f,9.810745120e-01f,7.814403772e-01f,-7.174775004e-01f,-5.885011554e-01f,3.274895847e-01f,7.676045895e-01f,9.244439602e-01f,9.758974314e-01f,9.923570156e-01f,9.975810051e-01f,9.992348552e-01f,9.997580051e-01f,9.999234676e-01f,9.999758005e-01f,9.999923706e-01f,-5.328330398e-01f,9.332356453e-01f,5.486453176e-01f,-5.829432011e-01f,-6.662760377e-01f,2.738668323e-01f,7.469564080e-01f,9.175173044e-01f,9.736663699e-01f,9.916474223e-01f,9.973561764e-01f,9.991636872e-01f,9.997355342e-01f,9.999163747e-01f,9.999735355e-01f,9.999916553e-01f,4.241790175e-01f,5.979771614e-01f,2.614414692e-01f,-4.300231636e-01f,-7.373937368e-01f,2.193782479e-01f,7.255613208e-01f,9.103004336e-01f,9.713379741e-01f,9.909064770e-01f,9.971213937e-01f,9.990894198e-01f,9.997119904e-01f,9.999089241e-01f,9.999712110e-01f,9.999908805e-01f,9.912028313e-01f,7.855261862e-02f,-5.168941990e-02f,-2.635403872e-01f,-8.011436462e-01f,1.641961187e-01f,7.034407258e-01f,9.027957320e-01f,9.689124227e-01f,9.901341200e-01f,9.968766570e-01f,9.990119338e-01f,9.996874928e-01f,9.999011755e-01f,9.999687672e-01f,9.999901056e-01f,6.469193101e-01f,-4.650647044e-01f,-3.596942723e-01f,-8.874565363e-02f,-8.568887711e-01f,1.084948927e-01f,6.806167960e-01f,8.950055838e-01f,9.663899541e-01f,9.893305302e-01f,9.966219068e-01f,9.989313483e-01f,9.996620417e-01f,9.998931289e-01f,9.999662042e-01f,9.999893308e-01f,-2.921388149e-01f,-8.654505610e-01f,-6.320284605e-01f,8.884806931e-02f,-9.040721655e-01f,5.245067179e-02f,6.571123004e-01f,8.869323730e-01f,9.637709260e-01f,9.884956479e-01f,9.963572025e-01f,9.988475442e-01f,9.996355176e-01f,9.998847246e-01f,9.999635220e-01f,9.999884963e-01f,-9.626058936e-01f,-9.992934465e-01f,-8.416847587e-01f,2.636395693e-01f,-9.422223568e-01f,-3.759374376e-03f,6.329507232e-01f,8.785787225e-01f,9.610554576e-01f,9.876294732e-01f,9.960825443e-01f,9.987606406e-01f,9.996080399e-01f,9.998760223e-01f,9.999607801e-01f,9.999876022e-01f,-7.480575442e-01f,-8.253720999e-01f,-9.678716063e-01f,4.301159978e-01f,-9.709581733e-01f,-5.995753407e-02f,6.081562042e-01f,8.699471951e-01f,9.582439065e-01f,9.867320657e-01f,9.957979321e-01f,9.986705780e-01f,9.995795488e-01f,9.998670220e-01f,9.999579787e-01f,9.999867082e-01f,1.542514563e-01f,-3.972512186e-01f,-9.980751872e-01f,5.830267668e-01f,-9.899924994e-01f,-1.159661412e-01f,5.827536583e-01f,8.610406518e-01f,9.553365111e-01f,9.858034849e-01f,9.955033660e-01f,9.985772967e-01f,9.995500445e-01f,9.998577237e-01f,9.999549985e-01f,9.999857545e-01f,9.147423506e-01f,1.532158256e-01f,-9.293002486e-01f,7.175491452e-01f,-9.991351366e-01f,-1.716081202e-01f,5.567683578e-01f,8.518617749e-01f,9.523335695e-01f,9.848436713e-01f,9.951988459e-01f,9.984809160e-01f,9.995195270e-01f,9.998480678e-01f,9.999519587e-01f,9.999848008e-01f,8.342233896e-01f,6.564951539e-01f,-7.683671117e-01f,8.294403553e-01f,-9.982947707e-01f,-2.267075777e-01f,5.302263498e-01f,8.424135447e-01f,9.492354393e-01f,9.838528037e-01f,9.948843718e-01f,9.983813763e-01f,9.994880557e-01f,9.998381138e-01f,9.999487996e-01f,9.999837875e-01f,-1.327674743e-02f,9.575859904e-01f,-5.312353969e-01f,9.151714444e-01f,-9.874797463e-01f,-2.810903192e-01f,5.031541586e-01f,8.326989412e-01f,9.460423589e-01f,9.828307629e-01f,9.945599437e-01f,9.982786179e-01f,9.994555712e-01f,9.998278022e-01f,9.999455214e-01f,9.999827743e-01f,-8.485702872e-01f,9.637577534e-01f,-2.414214015e-01f,9.720383883e-01f,-9.667981863e-01f,-3.345844150e-01f,4.755788743e-01f,8.227210045e-01f,9.427546859e-01f,9.817776680e-01f,9.942255616e-01f,9.981727600e-01f,9.994220734e-01f,9.998172522e-01f,9.999421835e-01f,9.999817014e-01f,-9.036921859e-01f,6.731096506e-01f,7.233422250e-02f,9.982477427e-01f,-9.364566803e-01f,-3.870207071e-01f,4.475280344e-01f,8.124828935e-01f,9.393727183e-01f,9.806935191e-01f,9.938812256e-01f,9.980637431e-01f,9.993875623e-01f,9.998063445e-01f,9.999387264e-01f,9.999806285e-01f,-1.279636919e-01f,1.751560569e-01f,3.789165020e-01f,9.929728508e-01f,-8.967583776e-01f,-4.382334948e-01f,4.190297127e-01f,8.019878864e-01f,9.358968139e-01f,9.795783162e-01f,9.935269952e-01f,9.979515672e-01f,9.993520975e-01f,9.997950792e-01f,9.999352098e-01f,9.999794960e-01f,7.654140592e-01f,-3.767423928e-01f,6.479218602e-01f,9.563800097e-01f,-8.481000066e-01f,-4.880608022e-01f,3.901124001e-01f,7.912392616e-01f,9.323273301e-01f,9.784321785e-01f,9.931628108e-01f,9.978361726e-01f,9.993155599e-01f,9.997835755e-01f,9.999315739e-01f,9.999783635e-01f,9.550736547e-01f,-8.126110435e-01f,8.526731730e-01f,8.896234035e-01f,-7.909677029e-01f,-5.363451242e-01f,3.608050048e-01f,7.802404165e-01f,9.286646247e-01f,9.772551060e-01f,9.927886724e-01f,9.977176785e-01f,9.992780685e-01f,9.997717142e-01f,9.999278188e-01f,9.999771714e-01f,2.666429281e-01f,-9.982103109e-01f,9.728653431e-01f,7.948085070e-01f,-7.259322405e-01f,-5.829338431e-01f,3.311368227e-01f,7.689948678e-01f,9.249090552e-01f,9.760470986e-01f,9.924046397e-01f,9.975960255e-01f,9.992396235e-01f,9.997594953e-01f,9.999239445e-01f,9.999759793e-01f,-6.669380665e-01f,-8.763789535e-01f,9.965789914e-01f,6.749257445e-01f,-6.536435485e-01f,-6.276796460e-01f,3.011375368e-01f,7.575061917e-01f,9.210609794e-01f,9.748082757e-01f,9.920106530e-01f,9.974712729e-01f,9.992001057e-01f,9.997470379e-01f,9.999200106e-01f,9.999747276e-01f,-9.873392582e-01f,-4.846388698e-01f,9.214624763e-01f,5.337561369e-01f,-5.748239160e-01f,-6.704410911e-01f,2.708371282e-01f,7.457779050e-01f,9.171208143e-01f,9.735385776e-01f,9.916067719e-01f,9.973433018e-01f,9.991596341e-01f,9.997342229e-01f,9.999159575e-01f,9.999734163e-01f,-3.999853134e-01f,5.636117980e-02f,7.549650669e-01f,3.757520616e-01f,-4.902607799e-01f,-7.110829353e-01f,2.402659208e-01f,7.338138223e-01f,9.130889177e-01f,9.722381234e-01f,9.911929369e-01f,9.972121716e-01f,9.991181493e-01f,9.997211099e-01f,9.999117851e-01f,9.999721050e-01f,5.551133156e-01f,5.800030231e-01f,5.135982037e-01f,2.058969885e-01f,-4.007991254e-01f,-7.494767904e-01f,2.094544619e-01f,7.216176987e-01f,9.089657664e-01f,9.709069133e-01f,9.907692075e-01f,9.970778823e-01f,9.990756512e-01f,9.997076392e-01f,9.999075532e-01f,9.999707937e-01f,9.998432994e-01f,9.250144958e-01f,2.212980539e-01f,2.954799868e-02f,-3.073328137e-01f,-7.855011225e-01f,1.784335524e-01f,7.091933489e-01f,9.047516584e-01f,9.695450068e-01f,9.903355837e-01f,9.969404936e-01f,9.990321398e-01f,9.996939301e-01f,9.999032021e-01f,9.999693632e-01f,5.253219604e-01f,9.851383567e-01f,-9.294807911e-02f,-1.477329135e-01f,-2.107957304e-01f,-8.190422058e-01f,1.472342461e-01f,6.965447664e-01f,9.004471302e-01f,9.681524634e-01f,9.898920655e-01f,9.967998862e-01f,9.989876747e-01f,9.996798635e-01f,9.998987317e-01f,9.999679923e-01f,-4.321779311e-01f,7.418575287e-01f,-3.979766071e-01f,-3.203544021e-01f,-1.121524572e-01f,-8.499939442e-01f,1.158877090e-01f,6.836758852e-01f,8.960524797e-01f,9.667292237e-01f,9.894386530e-01f,9.966561794e-01f,9.989421964e-01f,9.996654391e-01f,9.998942018e-01f,9.999665618e-01f,-9.923354983e-01f,2.700981200e-01f,-6.635380387e-01f,-4.828720689e-01f,-1.238859352e-02f,-8.782584071e-01f,8.442529291e-02f,6.705908775e-01f,8.915683031e-01f,9.652754664e-01f,9.889753461e-01f,9.965093136e-01f,9.988957047e-01f,9.996507764e-01f,9.998895526e-01f,9.999650717e-01f,-6.401443481e-01f,-2.848466039e-01f,-8.632967472e-01f,-6.301601529e-01f,8.749905229e-02f,-9.037463665e-01f,5.287845805e-02f,6.572937369e-01f,8.869948983e-01f,9.637911916e-01f,9.885020852e-01f,9.963592887e-01f,9.988481998e-01f,9.996357560e-01f,9.998847842e-01f,9.999635816e-01f,3.005925417e-01f,-7.520637512e-01f,-9.774428010e-01f,-7.575733066e-01f,1.865124404e-01f,-9.263771772e-01f,2.127875015e-02f,6.437888145e-01f,8.823328614e-01f,9.622764587e-01f,9.880189896e-01f,9.962061048e-01f,9.987997413e-01f,9.996203780e-01f,9.998799562e-01f,9.999620318e-01f,9.649659991e-01f,-9.876589775e-01f,-9.946563840e-01f,-8.610929251e-01f,2.836622596e-01f,-9.460792542e-01f,-1.034223381e-02f,6.300802827e-01f,8.775825500e-01f,9.607312679e-01f,9.875259995e-01f,9.960497618e-01f,9.987502694e-01f,9.996047616e-01f,9.998750091e-01f,9.999604821e-01f,7.421541810e-01f,-9.190732241e-01f,-9.132304788e-01f,-9.374541044e-01f,3.779778183e-01f,-9.627903700e-01f,-4.195287824e-02f,6.161725521e-01f,8.727445006e-01f,9.591556787e-01f,9.870231748e-01f,9.958902597e-01f,9.986997843e-01f,9.995887876e-01f,9.998699427e-01f,9.999588728e-01f,-1.629907787e-01f,-5.674296618e-01f,-7.412400246e-01f,-9.842483997e-01f,4.685167372e-01f,-9.764577150e-01f,-7.352156937e-02f,6.020699143e-01f,8.678191900e-01f,9.575498104e-01f,9.865104556e-01f,9.957276583e-01f,9.986482859e-01f,9.995725155e-01f,9.998648167e-01f,9.999572635e-01f,-9.182828069e-01f,-4.102807119e-02f,-4.957412183e-01f,-1.000000000e+00f,5.543743968e-01f,-9.870380163e-01f,-1.050167456e-01f,5.877768993e-01f,8.628070951e-01f,9.559136033e-01f,9.859878421e-01f,9.955618382e-01f,9.985958338e-01f,9.995558858e-01f,9.998595715e-01f,9.999555945e-01f,-8.293098211e-01f,4.980093837e-01f,-2.010800242e-01f,-9.842120409e-01f,6.346929669e-01f,-9.944978356e-01f,-1.364069134e-01f,5.732980371e-01f,8.577086926e-01f,9.542471766e-01f,9.854553938e-01f,9.953929186e-01f,9.985423684e-01f,9.995389581e-01f,9.998542070e-01f,9.999538660e-01f,2.212675661e-02f,8.836690187e-01f,1.135221645e-01f,-9.373825192e-01f,7.086698413e-01f,-9.988136292e-01f,-1.676606983e-01f,5.586379170e-01f,8.525245190e-01f,9.525505900e-01f,9.849131107e-01f,9.952208400e-01f,9.984878898e-01f,9.995217323e-01f,9.998487830e-01f,9.999521971e-01f,8.532201052e-01f,9.971746802e-01f,4.168664217e-01f,-8.609883785e-01f,7.755659223e-01f,-9.999717474e-01f,-1.987468153e-01f,5.438010693e-01f,8.472551107e-01f,9.508239031e-01f,9.843609333e-01f,9.950456619e-01f,9.984323978e-01f,9.995042086e-01f,9.998431802e-01f,9.999504089e-01f,8.998668194e-01f,8.035687208e-01f,6.788702607e-01f,-7.574390173e-01f,8.347128034e-01f,-9.979684949e-01f,-2.296342254e-01f,5.287923217e-01f,8.419010043e-01f,9.490671158e-01f,9.837989211e-01f,9.948672652e-01f,9.983759522e-01f,9.994863272e-01f,9.998375773e-01f,9.999486208e-01f,1.191801354e-01f,3.624782264e-01f,8.735509515e-01f,-6.300004721e-01f,8.855195642e-01f,-9.928101897e-01f,-2.602919936e-01f,5.136163235e-01f,8.364626765e-01f,9.472803473e-01f,9.832270741e-01f,9.946857691e-01f,9.983184934e-01f,9.994681478e-01f,9.998317957e-01f,9.999468327e-01f,-7.710801959e-01f,-1.902489811e-01f,9.816020727e-01f,-4.826919436e-01f,9.274784923e-01f,-9.845131636e-01f,-2.906895280e-01f,4.982779622e-01f,8.309406638e-01f,9.454635978e-01f,9.826454520e-01f,9.945011139e-01f,9.982600212e-01f,9.994496703e-01f,9.998259544e-01f,9.999449849e-01f,-9.524129629e-01f,-6.843829751e-01f,9.923082590e-01f,-3.201595843e-01f,9.601703286e-01f,-9.731037021e-01f,-3.207963705e-01f,4.827819765e-01f,8.253356218e-01f,9.436169863e-01f,9.820539355e-01f,9.943132997e-01f,9.982005358e-01f,9.994308352e-01f,9.998199940e-01f,9.999430776e-01f,-2.581016421e-01f,-9.677394629e-01f,9.046077728e-01f,-1.475295126e-01f,9.832684398e-01f,-9.586178064e-01f,-3.505824506e-01f,4.671333730e-01f,8.196480274e-01f,9.417404532e-01f,9.814526439e-01f,9.941223264e-01f,9.981400967e-01f,9.994117022e-01f,9.998139739e-01f,9.999411702e-01f,6.735071540e-01f,-9.530498385e-01f,7.271978855e-01f,2.975356206e-02f,9.965420961e-01f,-9.411013126e-01f,-3.800179660e-01f,4.513370097e-01f,8.138784766e-01f,9.398342371e-01f,9.808415174e-01f,9.939282537e-01f,9.980786443e-01f,9.993922710e-01f,9.998078346e-01f,9.999392033e-01f,9.858965874e-01f,-6.448382139e-01f,4.776721597e-01f,2.060982287e-01f,9.998586178e-01f,-9.206095338e-01f,-4.090735018e-01f,4.353979528e-01f,8.080275059e-01f,9.378982186e-01f,9.802205563e-01f,9.937310219e-01f,9.980161786e-01f,9.993724823e-01f,9.998015761e-01f,9.999372363e-01f};
__device__ const float ROPE_S[1024] = {0.000000000e+00f,0.000000000e+00f,0.000000000e+00f,0.000000000e+00f,0.000000000e+00f,0.000000000e+00f,0.000000000e+00f,0.000000000e+00f,0.000000000e+00f,0.000000000e+00f,0.000000000e+00f,0.000000000e+00f,0.000000000e+00f,0.000000000e+00f,0.000000000e+00f,0.000000000e+00f,8.414709568e-01f,5.331684351e-01f,3.109835982e-01f,1.768921912e-01f,9.983342141e-02f,5.620449781e-02f,3.161750361e-02f,1.778185740e-02f,9.999833070e-03f,5.623383448e-03f,3.162272274e-03f,1.778278500e-03f,9.999999311e-04f,5.623412435e-04f,3.162277571e-04f,1.778279402e-04f,9.092974067e-01f,9.021307230e-01f,5.911270976e-01f,3.482052684e-01f,1.986693293e-01f,1.122313142e-01f,6.320339441e-02f,3.555808961e-02f,1.999866590e-02f,1.124658901e-02f,6.324512884e-03f,3.556551412e-03f,1.999998698e-03f,1.124682371e-03f,6.324554561e-04f,3.556558804e-04f,1.411200017e-01f,9.932531714e-01f,8.126488924e-01f,5.085361600e-01f,2.955202162e-01f,1.679033041e-01f,9.472608566e-02f,5.332308263e-02f,2.999549918e-02f,1.686943881e-02f,9.486690164e-03f,5.334813148e-03f,2.999995602e-03f,1.687023090e-03f,9.486831259e-04f,5.334838061e-04f,-7.568024993e-01f,7.784717083e-01f,9.535807371e-01f,6.528279781e-01f,3.894183338e-01f,2.230444849e-01f,1.261540651e-01f,7.107120752e-02f,3.998933360e-02f,2.249175683e-02f,1.264877338e-02f,7.113057654e-03f,3.999989480e-03f,2.249363344e-03f,1.264910679e-03f,7.113117026e-04f,-9.589242935e-01f,3.239351809e-01f,9.999465346e-01f,7.765299678e-01f,4.794255495e-01f,2.774805427e-01f,1.574558914e-01f,8.879686147e-02f,4.997916892e-02f,2.811336145e-02f,1.581072994e-02f,8.891279809e-03f,4.999979399e-03f,2.811702900e-03f,1.581138116e-03f,8.891395992e-04f,-2.794154882e-01f,-2.303675115e-01f,9.471481442e-01f,8.757405877e-01f,5.646424890e-01f,3.310393393e-01f,1.886002719e-01f,1.064944416e-01f,5.996400490e-02f,3.373407945e-02f,1.897252724e-02f,1.066947449e-02f,5.999964196e-03f,3.374041524e-03f,1.897365437e-03f,1.066967496e-03f,6.569865942e-01f,-7.137212157e-01f,8.004216552e-01f,9.473307133e-01f,6.442176700e-01f,3.835515678e-01f,2.195560783e-01f,1.241583377e-01f,6.994284689e-02f,3.935372829e-02f,2.213413641e-02f,1.244763471e-02f,6.999942940e-03f,3.936378751e-03f,2.213592408e-03f,1.244795276e-03f,9.893582463e-01f,-9.772617817e-01f,5.743177533e-01f,9.890424609e-01f,7.173560858e-01f,4.348512292e-01f,2.502923310e-01f,1.417829692e-01f,7.991468906e-02f,4.497213289e-02f,2.529552206e-02f,1.422575582e-02f,7.999914698e-03f,4.498715047e-03f,2.529819263e-03f,1.422623056e-03f,4.121184945e-01f,-9.398235083e-01f,2.912591398e-01f,9.995602965e-01f,7.833269238e-01f,4.847761393e-01f,2.807783484e-01f,1.593627781e-01f,8.987854421e-02f,5.058911443e-02f,2.845665626e-02f,1.600383222e-02f,8.999878541e-03f,5.061049946e-03f,2.846045885e-03f,1.600450836e-03f,-5.440211296e-01f,-6.129366755e-01f,-2.068351023e-02f,9.785525203e-01f,8.414710164e-01f,5.331684351e-01f,3.109835684e-01f,1.768921912e-01f,9.983341396e-02f,5.620449781e-02f,3.161750734e-02f,1.778185740e-02f,9.999834001e-03f,5.623383448e-03f,3.162272274e-03f,1.778278500e-03f,-9.999902248e-01f,-9.727657586e-02f,-3.305749893e-01f,9.266815782e-01f,8.912073970e-01f,5.798751712e-01f,3.408778608e-01f,1.943656653e-01f,1.097782999e-01f,6.181810424e-02f,3.477803990e-02f,1.955982670e-02f,1.099977829e-02f,6.185715087e-03f,3.478498198e-03f,1.956106164e-03f,-5.365729332e-01f,4.483429790e-01f,-6.076835394e-01f,8.455835581e-01f,9.320390821e-01f,6.247486472e-01f,3.704313040e-01f,2.117776722e-01f,1.197122037e-01f,6.742975861e-02f,3.793822601e-02f,2.133773454e-02f,1.199971233e-02f,6.748044398e-03f,3.794723889e-03f,2.133933594e-03f,4.201670289e-01f,8.558810353e-01f,-8.245284557e-01f,7.378162742e-01f,9.635581970e-01f,6.676470041e-01f,3.996143341e-01f,2.291227132e-01f,1.296341419e-01f,7.303927839e-02f,4.109803215e-02f,2.311557345e-02f,1.299963426e-02f,7.310371846e-03f,4.110949114e-03f,2.311761258e-03f,9.906073809e-01f,9.998233318e-01f,-9.596053362e-01f,6.067785621e-01f,9.854497313e-01f,7.084347010e-01f,4.283977747e-01f,2.463953048e-01f,1.395431161e-01f,7.864648104e-02f,4.425742477e-02f,2.489333972e-02f,1.399954315e-02f,7.872696966e-03f,4.427174106e-03f,2.489588689e-03f,6.502878666e-01f,8.358382583e-01f,-9.995186925e-01f,4.566033483e-01f,9.974949956e-01f,7.469826341e-01f,4.567528665e-01f,2.635899782e-01f,1.494381279e-01f,8.425120264e-02f,4.741637781e-02f,2.667102776e-02f,1.499943808e-02f,8.435019292e-03f,4.743398633e-03f,2.667415887e-03f,-2.879033089e-01f,4.144302309e-01f,-9.403103590e-01f,2.920270860e-01f,9.995735884e-01f,7.831690907e-01f,4.846512377e-01f,2.807013094e-01f,1.593182087e-01f,8.985326439e-02f,5.057485774e-02f,2.844863199e-02f,1.599931903e-02f,8.997339755e-03f,5.059622694e-03f,2.845243318e-03f,-9.613974690e-01f,-1.346147805e-01f,-7.878519297e-01f,1.182404235e-01f,9.916648269e-01f,8.168795705e-01f,5.120649934e-01f,2.977238595e-01f,1.691823453e-01f,9.545248002e-02f,5.373283103e-02f,3.022614680e-02f,1.699918136e-02f,9.559656493e-03f,5.375845823e-03f,3.023070283e-03f,-7.509872317e-01f,-6.422008872e-01f,-5.572627187e-01f,-5.927548930e-02f,9.738476276e-01f,8.480075002e-01f,5.389667153e-01f,3.146522641e-01f,1.790295690e-01f,1.010486782e-01f,5.689026415e-02f,3.200356290e-02f,1.799902879e-02f,1.012197044e-02f,5.692068953e-03f,3.200897481e-03f,1.498772055e-01f,-9.520007968e-01f,-2.714100778e-01f,-2.349218726e-01f,9.463000894e-01f,8.764545321e-01f,5.653295517e-01f,3.314811885e-01f,1.888588965e-01f,1.066416800e-01f,6.004713103e-02f,3.378088027e-02f,1.899885759e-02f,1.068428159e-02f,6.008291151e-03f,3.378724447e-03f,9.129452705e-01f,-9.686018229e-01f,4.135817289e-02f,-4.031589329e-01f,9.092974067e-01f,9.021307230e-01f,5.911270976e-01f,3.482052684e-01f,1.986693293e-01f,1.122313142e-01f,6.320339441e-02f,3.555808961e-02f,1.999866776e-02f,1.124658901e-02f,6.324512884e-03f,3.556551412e-03f,8.366556168e-01f,-6.868911386e-01f,3.500249386e-01f,-5.586805344e-01f,8.632093668e-01f,9.249548316e-01f,6.163335443e-01f,3.648192585e-01f,2.084598988e-01f,1.178173944e-01f,6.635902822e-02f,3.733518720e-02f,2.099845745e-02f,1.180889271e-02f,6.640734151e-03f,3.734378144e-03f,-8.851309307e-03f,-1.936304569e-01f,6.239799261e-01f,-6.965816617e-01f,8.084963560e-01f,9.448547959e-01f,6.409237385e-01f,3.813178837e-01f,2.182296216e-01f,1.233997494e-01f,6.951399893e-02f,3.911216930e-02f,2.199822664e-02f,1.237119269e-02f,6.956954487e-03f,3.912204877e-03f,-8.462204337e-01f,3.592648506e-01f,8.360552192e-01f,-8.125128746e-01f,7.457051873e-01f,9.617676139e-01f,6.648730040e-01f,3.976959288e-01f,2.279775143e-01f,1.289782077e-01f,7.266827673e-02f,4.088902473e-02f,2.299797349e-02f,1.293348894e-02f,7.273174357e-03f,4.090031143e-03f,-9.055783749e-01f,8.015131354e-01f,9.652193189e-01f,-9.028178453e-01f,6.754631400e-01f,9.756398797e-01f,6.881574988e-01f,4.139482081e-01f,2.377026230e-01f,1.345525682e-01f,7.582182437e-02f,4.266574979e-02f,2.399769798e-02f,1.349578146e-02f,7.589393295e-03f,4.267857410e-03f,-1.323517561e-01f,9.969099760e-01f,9.986631870e-01f,-9.646483660e-01f,5.984721184e-01f,9.864277244e-01f,7.107539177e-01f,4.300695956e-01f,2.474039495e-01f,1.401226968e-01f,7.897461206e-02f,4.444234446e-02f,2.499739639e-02f,1.405806933e-02f,7.905611768e-03f,4.445683677e-03f,7.625584602e-01f,8.852766752e-01f,9.330702424e-01f,-9.960542917e-01f,5.155013204e-01f,9.940969944e-01f,7.326396108e-01f,4.460549653e-01f,2.570805550e-01f,1.456883848e-01f,8.212661743e-02f,4.621879384e-02f,2.599707246e-02f,1.462035254e-02f,8.221829310e-03f,4.623509943e-03f,9.563759565e-01f,5.009943247e-01f,7.749451399e-01f,-9.960451722e-01f,4.273798466e-01f,9.986234903e-01f,7.537927032e-01f,4.618993104e-01f,2.667314410e-01f,1.512494683e-01f,8.527779579e-02f,4.799509794e-02f,2.699672058e-02f,1.518263202e-02f,8.538045920e-03f,4.801335745e-03f,2.709057927e-01f,-3.758518398e-02f,5.399692655e-01f,-9.646212459e-01f,3.349881172e-01f,9.999929070e-01f,7.741920948e-01f,4.775975943e-01f,2.763556540e-01f,1.568057686e-01f,8.842812479e-02f,4.977125302e-02f,2.799634263e-02f,1.574490592e-02f,8.854261599e-03f,4.979161546e-03f,-6.636338830e-01f,-5.645891428e-01f,2.514448762e-01f,-9.027736187e-01f,2.392492890e-01f,9.982009530e-01f,7.938173413e-01f,4.931448400e-01f,2.859522104e-01f,1.623571068e-01f,9.157756716e-02f,5.154724792e-02f,2.899593674e-02f,1.630717516e-02f,9.170476347e-03f,5.156987347e-03f,-9.880316257e-01f,-9.177098870e-01f,-6.201513484e-02f,-8.124529719e-01f,1.411199570e-01f,9.932531714e-01f,8.126488924e-01f,5.085361600e-01f,2.955201864e-01f,1.679033041e-01f,9.472609311e-02f,5.332308263e-02f,2.999550104e-02f,1.686943881e-02f,9.486690164e-03f,5.334812682e-03f,-4.040376544e-01f,-9.881927371e-01f,-3.693251312e-01f,-6.965078712e-01f,4.158061743e-02f,9.851652980e-01f,8.306677938e-01f,5.237666368e-01f,3.050586283e-01f,1.734442115e-01f,9.787367284e-02f,5.509874597e-02f,3.099503741e-02f,1.743169688e-02f,9.802903049e-03f,5.512638018e-03f,5.514267087e-01f,-7.543302178e-01f,-6.400094032e-01f,-5.585952997e-01f,-5.837419257e-02f,9.739628434e-01f,8.478561044e-01f,5.388315320e-01f,3.145665526e-01f,1.789796203e-01f,1.010202691e-01f,5.687423423e-02f,3.199454024e-02f,1.799395122e-02f,1.011911593e-02f,5.690463353e-03f,9.999118447e-01f,-2.881477177e-01f,-8.472242355e-01f,-4.030648470e-01f,-1.577457488e-01f,9.596813321e-01f,8.641966581e-01f,5.537260175e-01f,3.240430355e-01f,1.845093668e-01f,1.041658595e-01f,5.864954740e-02f,3.299401328e-02f,1.855619811e-02f,1.043532696e-02f,5.868288223e-03f,5.290827155e-01f,2.667790353e-01f,-9.704203606e-01f,-2.348219305e-01f,-2.555411458e-01f,9.423657656e-01f,8.796730638e-01f,5.684453845e-01f,3.334870934e-01f,1.900332868e-01f,1.073104069e-01f,6.042467058e-02f,3.399345279e-02f,1.911843941e-02f,1.075153705e-02f,6.046113092e-03f,-4.281826615e-01f,7.395427227e-01f,-9.973804355e-01f,-5.917284265e-02f,-3.507832885e-01f,9.220710397e-01f,8.942698836e-01f,5.829849839e-01f,3.428978026e-01f,1.955511868e-01f,1.104538813e-01f,6.219960377e-02f,3.499285504e-02f,1.968067512e-02f,1.106774528e-02f,6.223937497e-03f,-9.917788506e-01f,9.845407009e-01f,-9.254308343e-01f,1.183425263e-01f,-4.425204992e-01f,8.988611698e-01f,9.079725146e-01f,5.973402858e-01f,3.522742391e-01f,2.010629177e-01f,1.135962531e-01f,6.397434324e-02f,3.599222749e-02f,2.024290338e-02f,1.138395350e-02f,6.401761901e-03f,-6.435381174e-01f,9.263180494e-01f,-7.617068291e-01f,2.921254337e-01f,-5.298361778e-01f,8.728096485e-01f,9.207672477e-01f,6.115067005e-01f,3.616154194e-01f,2.065682858e-01f,1.167374924e-01f,6.574887782e-02f,3.699155897e-02f,2.080512606e-02f,1.170015987e-02f,6.579586305e-03f,2.963685691e-01f,5.828063488e-01f,-5.224447250e-01f,4.566948116e-01f,-6.118579507e-01f,8.439987302e-01f,9.326412678e-01f,6.254796982e-01f,3.709204495e-01f,2.120671123e-01f,1.198775545e-01f,6.752320379e-02f,3.799085692e-02f,2.136734314e-02f,1.201636530e-02f,6.757410243e-03f,9.637953639e-01f,5.980091169e-02f,-2.313721031e-01f,6.068602800e-01f,-6.877661943e-01f,8.125196099e-01f,9.435827732e-01f,6.392549276e-01f,3.801884055e-01f,2.175592482e-01f,1.230164245e-01f,6.929731369e-02f,3.899011761e-02f,2.192955278e-02f,1.233256981e-02f,6.935234182e-03f,7.451131344e-01f,-4.816221297e-01f,8.264556527e-02f,7.378856540e-01f,-7.568025589e-01f,7.784717679e-01f,9.535807371e-01f,6.528280377e-01f,3.894183338e-01f,2.230444849e-01f,1.261540651e-01f,7.107120752e-02f,3.998933733e-02f,2.249175496e-02f,1.264877338e-02f,7.113057654e-03f,-1.586226672e-01f,-8.747143149e-01f,3.884673417e-01f,8.456384540e-01f,-8.182771206e-01f,7.419627905e-01f,9.626252055e-01f,6.661946774e-01f,3.986093104e-01f,2.285226882e-01f,1.292904466e-01f,7.284487784e-02f,4.098851606e-02f,2.305395156e-02f,1.296497509e-02f,7.290881127e-03f,-9.165215492e-01f,-9.984104633e-01f,6.557649970e-01f,9.267202020e-01f,-8.715758324e-01f,7.031081319e-01f,9.707071185e-01f,6.793506145e-01f,4.077604413e-01f,2.339936495e-01f,1.324255317e-01f,7.461831719e-02f,4.198765382e-02f,2.361613885e-02f,1.328117494e-02f,7.468704134e-03f,-8.317747712e-01f,-8.146143556e-01f,8.580308557e-01f,9.785736799e-01f,-9.161659479e-01f,6.620306373e-01f,9.778184295e-01f,6.922917962e-01f,4.168708026e-01f,2.394572198e-01f,1.355592906e-01f,7.639151812e-02f,4.298675060e-02f,2.417832054e-02f,1.359737478e-02f,7.646527141e-03f,1.770192571e-02f,-3.799318373e-01f,9.752061963e-01f,9.995633364e-01f,-9.516021013e-01f,6.188601851e-01f,9.839519858e-01f,7.050140500e-01f,4.259394705e-01f,2.449132204e-01f,1.386916935e-01f,7.816448063e-02f,4.398580641e-02f,2.474049293e-02f,1.391357277e-02f,7.824349217e-03f,8.509035110e-01f,1.717627496e-01f,9.956709743e-01f,9.890273213e-01f,-9.775301218e-01f,5.737332702e-01f,9.891016483e-01f,7.175133228e-01f,4.349655211e-01f,2.503614724e-01f,1.418227106e-01f,7.993719727e-02f,4.498481750e-02f,2.530265786e-02f,1.422976889e-02f,8.002172224e-03f,9.017883539e-01f,6.705575585e-01f,9.173955917e-01f,9.472977519e-01f,-9.936910272e-01f,5.267924666e-01f,9.932623506e-01f,7.297857404e-01f,4.439480901e-01f,2.558017969e-01f,1.449523121e-01f,8.170966059e-02f,4.598378018e-02f,2.586481534e-02f,1.454596408e-02f,8.179994300e-03f,1.235731244e-01f,9.628328085e-01f,7.481426001e-01f,8.756909370e-01f,-9.999232292e-01f,4.781862795e-01f,9.964298010e-01f,7.418274283e-01f,4.528862834e-01f,2.612340450e-01f,1.480804533e-01f,8.348186314e-02f,4.698270187e-02f,2.642696351e-02f,1.486215740e-02f,8.357815444e-03f,-7.682546377e-01f,9.585731030e-01f,5.046967268e-01f,7.764651775e-01f,-9.961646199e-01f,4.280683398e-01f,9.986009598e-01f,7.536344528e-01f,4.617791772e-01f,2.666580379e-01f,1.512071192e-01f,8.525379747e-02f,4.798157141e-02f,2.698910423e-02f,1.517834980e-02f,8.535637520e-03f,-9.537526369e-01f,6.590903401e-01f,2.112003416e-01f,6.527500749e-01f,-9.824525714e-01f,3.765970767e-01f,9.997735620e-01f,7.652032375e-01f,4.706258774e-01f,2.720735967e-01f,1.543322802e-01f,8.702547103e-02f,4.898039624e-02f,2.755123749e-02f,1.549454033e-02f,8.713458665e-03f,-2.623748481e-01f,1.566197872e-01f,-1.032406390e-01f,5.084475875e-01f,-9.589242339e-01f,3.239352107e-01f,9.999465346e-01f,7.765299678e-01f,4.794255197e-01f,2.774805427e-01f,1.574558914e-01f,8.879686147e-02f,4.997917265e-02f,2.811335959e-02f,1.581072994e-02f,8.891279809e-03f,6.702291965e-01f,-3.940868378e-01f,-4.074433148e-01f,3.481088877e-01f,-9.258146286e-01f,2.702492476e-01f,9.991195798e-01f,7.876111865e-01f,4.881772399e-01f,2.828786969e-01f,1.605779380e-01f,9.056797624e-02f,5.097789690e-02f,2.867547423e-02f,1.612691581e-02f,9.069100954e-03f,9.866275787e-01f,-8.234218955e-01f,-6.712400317e-01f,1.767909825e-01f,-8.834546208e-01f,2.157088965e-01f,9.972936511e-01f,7.984433770e-01f,4.968801141e-01f,2.882679403e-01f,1.636983752e-01f,9.233880043e-02f,5.197657272e-02f,2.923758142e-02f,1.644310169e-02f,9.246921167e-03f,3.959251642e-01f,-9.991579652e-01f,-8.684703112e-01f,-1.028269617e-04f,-8.322674036e-01f,1.604866087e-01f,9.944704771e-01f,8.090230227e-01f,5.055333376e-01f,2.936480343e-01f,1.668171585e-01f,9.410934150e-02f,5.297519267e-02f,2.979967743e-02f,1.675928570e-02f,9.424741380e-03f,-5.587890744e-01f,-8.671716452e-01f,-9.795747995e-01f,-1.769933850e-01f,-7.727644444e-01f,1.047569439e-01f,9.906529188e-01f,8.193469048e-01f,5.141359568e-01f,2.990188599e-01f,1.699342877e-01f,9.587957710e-02f,5.397376418e-02f,3.036176413e-02f,1.707546972e-02f,9.602561593e-03f,-9.997551441e-01f,-4.681122005e-01f,-9.935354590e-01f,-3.483016491e-01f,-7.055402398e-01f,4.869610071e-02f,9.858447313e-01f,8.294116855e-01f,5.226871967e-01f,3.043802381e-01f,1.730497181e-01f,9.764950722e-02f,5.497227609e-02f,3.092384152e-02f,1.739165001e-02f,9.780380875e-03f,-5.215510130e-01f,7.511726022e-02f,-9.089677334e-01f,-5.086246729e-01f,-6.312665939e-01f,-7.518695667e-03f,9.800508618e-01f,8.392141461e-01f,5.311861634e-01f,3.097319901e-01f,1.761634201e-01f,9.941913933e-02f,5.597073957e-02f,3.148590773e-02f,1.770782843e-02f,9.958200157e-03f,4.361647666e-01f,5.952119827e-01f,-7.342582345e-01f,-6.529058814e-01f,-5.506854653e-01f,-6.370972097e-02f,9.732770324e-01f,8.487512469e-01f,5.396320224e-01f,3.150739372e-01f,1.792753637e-01f,1.011884436e-01f,5.696914345e-02f,3.204796463e-02f,1.802400686e-02f,1.013601944e-02f,9.928726554e-01f,9.319922328e-01f,-4.867327213e-01f,-7.765947580e-01f,-4.646021128e-01f,-1.196993291e-01f,9.655299187e-01f,8.580199480e-01f,5.480239391e-01f,3.204059303e-01f,1.823855042e-01f,1.029574350e-01f,5.796748772e-02f,3.261001408e-02f,1.834018156e-02f,1.031383779e-02f,6.367380023e-01f,9.817358851e-01f,-1.909382045e-01f,-8.757901788e-01f,-3.738765717e-01f,-1.753105223e-01f,9.568174481e-01f,8.670173287e-01f,5.563610196e-01f,3.257277906e-01f,1.854938269e-01f,1.047261059e-01f,5.896577984e-02f,3.317204863e-02f,1.865635440e-02f,1.049165614e-02f,-3.048106134e-01f,7.291227579e-01f,1.237915382e-01f,-9.473636150e-01f,-2.794153988e-01f,-2.303674668e-01f,9.471482038e-01f,8.757405877e-01f,5.646424890e-01f,3.310393393e-01f,1.886002868e-01f,1.064944416e-01f,5.996400863e-02f,3.373407573e-02f,1.897252724e-02f,1.066947356e-02f,-9.661177993e-01f,2.519530654e-01f,4.262449443e-01f,-9.890576601e-01f,-1.821624190e-01f,-2.846961319e-01f,9.365319014e-01f,8.841868639e-01f,5.728674531e-01f,3.363404274e-01f,1.917048693e-01f,1.082624346e-01f,6.096218154e-02f,3.429609165e-02f,1.928869635e-02f,1.084729191e-02f,-7.391806841e-01f,-3.028135300e-01f,6.864278913e-01f,-9.995572567e-01f,-8.308931440e-02f,-3.381247520e-01f,9.249790907e-01f,8.923535943e-01f,5.810351372e-01f,3.416308761e-01f,1.948075294e-01f,1.100300923e-01f,6.196028739e-02f,3.485809639e-02f,1.960486546e-02f,1.102510933e-02f,1.673557013e-01f,-7.643191218e-01f,8.785381913e-01f,-9.785313010e-01f,1.681399345e-02f,-3.904843926e-01f,9.125014544e-01f,9.002380967e-01f,5.891447663e-01f,3.469105065e-01f,1.979082376e-01f,1.117973998e-01f,6.295833737e-02f,3.542008996e-02f,1.992103085e-02f,1.120292582e-02f};
namespace pg8 {
#define PG8_LAS __attribute__((address_space(3)))
typedef unsigned short bf16_t;
typedef short bf16x8 __attribute__((ext_vector_type(8)));
typedef float f32x4 __attribute__((ext_vector_type(4)));
typedef unsigned u32x4 __attribute__((ext_vector_type(4)));
constexpr int BM = 256, BK = 64, HALF = 128, HTB = HALF * BK * 2  , STAGE_BYTES = 8 * HTB, NXCD = 8, WGM = 8;

__host__ __device__ __forceinline__ int lds_byte(int r, int c) { const int st = (r >> 4) * 2 + (c >> 5), rr = r & 15, cc = c & 31, ob = rr * 64 + cc * 2; return st * 1024 + (ob ^ (((ob >> 9) & 1) << 5)); }
__host__ __device__ __forceinline__ void stage_rc(int b, int& R, int& C) { const int st = b / 1024, sb = b % 1024, swz = sb ^ (((sb >> 9) & 1) << 5); R = (st >> 1) * 16 + swz / 64; C = (st & 1) * 32 + (swz % 64) / 2; }
__host__ __device__ __forceinline__ int perm32(int rho) { const int n = rho >> 4, i = rho & 15; return 8 * (i >> 2) + 4 * n + (i & 3); }

struct Unit { int pm, pn, kb, nt; };
struct Gemm { const bf16_t* A; const bf16_t* Bt; int M, N, K; };

struct StaticOrder {
    int nM, nN, nwg, G, c, ntf;
    __host__ __device__ void init(int M, int N, int G_, int c_, int K_ = 1024) { nM = M / BM; nN = N / BM; nwg = nM * nN; G = G_; c = c_; ntf = K_ / BK; }
    __host__ __device__ bool next(int i, Unit& u) const {
        const long L = (long)i * G + c; if (L >= nwg) return false;
        int wgid = (int)L; { const int q = nwg / NXCD, r = nwg % NXCD, xcd = wgid % NXCD, off = wgid / NXCD; wgid = (xcd < r ? xcd * (q + 1) : r * (q + 1) + (xcd - r) * q) + off; }
        const int nig = WGM * nN, gid = wgid / nig, fm = gid * WGM, gsz = (nM - fm) < WGM ? (nM - fm) : WGM;
        u.pm = fm + ((wgid % nig) % gsz); u.pn = (wgid % nig) / gsz; u.kb = 0; u.nt = ntf; return true;
    }
    __device__ __forceinline__ void a_ready(const Unit&) const {}
    __device__ __forceinline__ void done(const Unit&) const {}
};
__device__ __forceinline__ unsigned cvt_pk_bf16(float lo, float hi) { unsigned r; asm volatile("v_cvt_pk_bf16_f32 %0, %1, %2" : "=v"(r) : "v"(lo), "v"(hi)); return r; }
typedef float f32x2 __attribute__((ext_vector_type(2)));
template <class Epi, class Sched, bool ALIGN_EPI = false, bool SP2 = false>
__device__ __forceinline__ void gemm_phase(PG8_LAS unsigned char* lds, const Gemm g, const Sched& S, const Epi& E) {
    int tid_ = threadIdx.x; asm volatile("" : "+v"(tid_)); const int tid = tid_, wid = __builtin_amdgcn_readfirstlane(tid >> 6), lane = tid & 63, wr = wid >> 2, wc = wid & 3, fr = lane & 15, fq = lane >> 4;
    const int K = g.K;
    unsigned voffA[2], voffB[2];
#pragma unroll
    for (int i = 0; i < 2; ++i) { int R, C; stage_rc(tid * 16 + i * 8192, R, C); const int Rb = Epi::PERM ? ((R & ~31) + perm32(R & 31)) : R;
        voffA[i] = (unsigned)(R * K + C) * 2u; voffB[i] = (unsigned)(Rb * K + C) * 2u; }
    const size_t kstep = (size_t)(BK * 2);
    const size_t hstep = (size_t)HALF * K * 2;
    const size_t tstep = 2 * hstep;
    const unsigned ldsw = (unsigned)wid * 1024u;
    const int aoff = lds_byte(wr * 64 + fr, fq * 8), boff = lds_byte(wc * 32 + fr, fq * 8);
#define PG8_SA(b, h) (((b) * 2 + (h)) * HTB)
#define PG8_SB(b, h) ((4 + (b) * 2 + (h)) * HTB)
#define PG8_STAGE(bufoff, gbase, voff) do { _Pragma("unroll") for (int _i = 0; _i < 2; ++_i) \
        __builtin_amdgcn_global_load_lds((const unsigned*)((const char*)(gbase) + (voff)[_i]), (PG8_LAS unsigned*)(lds + (bufoff) + ldsw + _i * 8192), 16, 0, 0); } while (0)
#define PG8_LDA(dst, b, h) do { _Pragma("unroll") for (int m = 0; m < 4; ++m) _Pragma("unroll") for (int k = 0; k < 2; ++k) dst[m][k] = *(const PG8_LAS bf16x8*)(lds + PG8_SA(b, h) + aoff + m * 2048 + k * 1024); } while (0)
#define PG8_LDB(dst, b, h) do { _Pragma("unroll") for (int n = 0; n < 2; ++n) _Pragma("unroll") for (int k = 0; k < 2; ++k) dst[n][k] = *(const PG8_LAS bf16x8*)(lds + PG8_SB(b, h) + boff + n * 2048 + k * 1024); } while (0)
#define PG8_MMA(ai, bj, At, Bt) do { __builtin_amdgcn_s_setprio(1); _Pragma("unroll") for (int m = 0; m < 4; ++m) _Pragma("unroll") for (int n = 0; n < 2; ++n) _Pragma("unroll") for (int k = 0; k < 2; ++k) \
        acc[ai][bj][m][n] = __builtin_amdgcn_mfma_f32_16x16x32_bf16(Bt[n][k], At[m][k], acc[ai][bj][m][n], 0, 0, 0); __builtin_amdgcn_s_setprio(0); } while (0)
#define PG8_WAIT_V(n) asm volatile("s_waitcnt vmcnt(" #n ")" ::: "memory")
#define PG8_WAIT_L(n) asm volatile("s_waitcnt lgkmcnt(" #n ")" ::: "memory")
#define PG8_BAR __builtin_amdgcn_s_barrier()
#define PG8_SCHED __builtin_amdgcn_sched_barrier(0)
    Unit cur, nxt; int ui = 0;
    if (!S.next(0, cur)) return;
    f32x4 acc[2][2][4][2];
#pragma unroll
    for (int a = 0; a < 2; ++a)
#pragma unroll
        for (int b = 0; b < 2; ++b)
#pragma unroll
            for (int m = 0; m < 4; ++m)
#pragma unroll
                for (int n = 0; n < 2; ++n) acc[a][b][m][n] = (f32x4){0.f, 0.f, 0.f, 0.f};
    bf16x8 At[4][2], B0[2][2], B1[2][2];
    const char* cA = (const char*)g.A + (size_t)cur.pm * tstep + (size_t)cur.kb * kstep; const char* cB = (const char*)g.Bt + (size_t)cur.pn * tstep + (size_t)cur.kb * kstep;
    S.a_ready(cur);
    if constexpr (SP2) {
        PG8_STAGE(PG8_SB(0, 0), cB, voffB); PG8_STAGE(PG8_SB(0, 1), cB + hstep, voffB); PG8_STAGE(PG8_SA(0, 0), cA, voffA); PG8_STAGE(PG8_SA(0, 1), cA + hstep, voffA);
        if (wr == 1) PG8_BAR;
        PG8_WAIT_V(2); PG8_BAR;
        PG8_STAGE(PG8_SB(1, 0), cB + kstep, voffB); PG8_STAGE(PG8_SA(1, 0), cA + kstep, voffA); PG8_STAGE(PG8_SB(1, 1), cB + hstep + kstep, voffB);
        PG8_WAIT_V(6); PG8_BAR;
    } else {
        PG8_STAGE(PG8_SB(0, 0), cB, voffB); PG8_STAGE(PG8_SA(0, 0), cA, voffA); PG8_STAGE(PG8_SB(0, 1), cB + hstep, voffB); PG8_STAGE(PG8_SA(0, 1), cA + hstep, voffA);
        if (wr == 1) PG8_BAR;
        PG8_WAIT_V(4); PG8_BAR;
        PG8_STAGE(PG8_SB(1, 0), cB + kstep, voffB); PG8_STAGE(PG8_SA(1, 0), cA + kstep, voffA); PG8_STAGE(PG8_SB(1, 1), cB + hstep + kstep, voffB);
        PG8_WAIT_V(6); PG8_BAR;
    }
    for (;;) {
        const bool has_next = S.next(ui + 1, nxt);
        const char* nA = has_next ? (const char*)g.A + (size_t)nxt.pm * tstep + (size_t)nxt.kb * kstep : cA; const char* nB = has_next ? (const char*)g.Bt + (size_t)nxt.pn * tstep + (size_t)nxt.kb * kstep : cB;
        const int nt = cur.nt;
        for (int t = 0; t < nt; t += 2) {
            const bool last = (t == nt - 2);
            const char* a1 = cA + (size_t)(t + 1) * kstep;
            const char* a2 = last ? nA : cA + (size_t)(t + 2) * kstep; const char* b2 = last ? nB : cB + (size_t)(t + 2) * kstep;
            const char* a3 = a2 + kstep; const char* b3 = b2 + kstep;
            if (last && has_next) S.a_ready(nxt);
            if constexpr (SP2) {
            PG8_LDB(B0, 0, 0); PG8_LDB(B1, 0, 1); PG8_SCHED; PG8_LDA(At, 0, 0); PG8_STAGE(PG8_SA(1, 1), a1 + hstep, voffA);
            PG8_WAIT_V(8); PG8_WAIT_L(0); PG8_BAR; PG8_MMA(0, 0, At, B0); PG8_MMA(0, 1, At, B1); PG8_BAR; PG8_SCHED;
            PG8_LDA(At, 0, 1); PG8_STAGE(PG8_SB(0, 0), b2, voffB); PG8_STAGE(PG8_SB(0, 1), b2 + hstep, voffB); PG8_STAGE(PG8_SA(0, 0), a2, voffA);
            PG8_WAIT_V(8); PG8_WAIT_L(0); PG8_BAR; PG8_MMA(1, 0, At, B0); PG8_MMA(1, 1, At, B1); PG8_BAR; PG8_SCHED;
            PG8_LDB(B0, 1, 0); PG8_LDB(B1, 1, 1); PG8_SCHED; PG8_LDA(At, 1, 0); PG8_STAGE(PG8_SA(0, 1), a2 + hstep, voffA);
            PG8_WAIT_V(8); PG8_WAIT_L(0); PG8_BAR; PG8_MMA(0, 0, At, B0); PG8_MMA(0, 1, At, B1); PG8_BAR; PG8_SCHED;
            PG8_LDA(At, 1, 1); PG8_STAGE(PG8_SB(1, 0), b3, voffB); PG8_STAGE(PG8_SB(1, 1), b3 + hstep, voffB); PG8_STAGE(PG8_SA(1, 0), a3, voffA);
            PG8_WAIT_V(8); PG8_WAIT_L(0); PG8_BAR; PG8_MMA(1, 0, At, B0); PG8_MMA(1, 1, At, B1); PG8_BAR; PG8_SCHED;
            } else {
            PG8_LDB(B0, 0, 0); PG8_SCHED; PG8_LDA(At, 0, 0); PG8_STAGE(PG8_SA(1, 1), a1 + hstep, voffA);
            PG8_WAIT_L(8); PG8_BAR; PG8_WAIT_L(0); PG8_MMA(0, 0, At, B0); PG8_BAR; PG8_SCHED;
            PG8_LDB(B1, 0, 1); PG8_STAGE(PG8_SB(0, 0), b2, voffB);
            PG8_BAR; PG8_WAIT_L(0); PG8_MMA(0, 1, At, B1); PG8_BAR;
            PG8_LDA(At, 0, 1); PG8_STAGE(PG8_SA(0, 0), a2, voffA);
            PG8_BAR; PG8_WAIT_L(0); PG8_MMA(1, 0, At, B0); PG8_BAR; PG8_SCHED;
            PG8_STAGE(PG8_SB(0, 1), b2 + hstep, voffB);
            PG8_WAIT_V(6); PG8_BAR; PG8_MMA(1, 1, At, B1); PG8_BAR;
            PG8_LDB(B0, 1, 0); PG8_SCHED; PG8_LDA(At, 1, 0); PG8_STAGE(PG8_SA(0, 1), a2 + hstep, voffA);
            PG8_WAIT_L(8); PG8_BAR; PG8_WAIT_L(0); PG8_MMA(0, 0, At, B0); PG8_BAR; PG8_SCHED;
            PG8_LDB(B1, 1, 1); PG8_STAGE(PG8_SB(1, 0), b3, voffB);
            PG8_BAR; PG8_WAIT_L(0); PG8_MMA(0, 1, At, B1); PG8_BAR;
            PG8_LDA(At, 1, 1); PG8_STAGE(PG8_SA(1, 0), a3, voffA);
            PG8_BAR; PG8_WAIT_L(0); PG8_MMA(1, 0, At, B0); PG8_BAR; PG8_SCHED;
            PG8_STAGE(PG8_SB(1, 1), b3 + hstep, voffB);
            PG8_WAIT_V(6); PG8_BAR; PG8_MMA(1, 1, At, B1); PG8_BAR;
            }
        }
        if constexpr (ALIGN_EPI) { if (wr == 0) PG8_BAR; }
        if constexpr (!Epi::AFTER_DRAIN) { E(acc, cur, wr, wc, fr, fq); S.done(cur); }
        if (!has_next) break;
#pragma unroll
        for (int a = 0; a < 2; ++a)
#pragma unroll
            for (int b = 0; b < 2; ++b)
#pragma unroll
                for (int m = 0; m < 4; ++m)
#pragma unroll
                    for (int n = 0; n < 2; ++n) acc[a][b][m][n] = (f32x4){0.f, 0.f, 0.f, 0.f};
        cur = nxt; cA = nA; cB = nB; ++ui;
        if constexpr (ALIGN_EPI) { if (wr == 1) PG8_BAR; }
    }
    PG8_WAIT_V(0);
    if constexpr (!ALIGN_EPI) { if (wr == 0) PG8_BAR; }
    PG8_BAR;
    if constexpr (Epi::AFTER_DRAIN) { E.fused(acc, cur, wr, wc, fr, fq, lds, wid, lane); S.done(cur); }
#undef PG8_SA
#undef PG8_SB
#undef PG8_STAGE
#undef PG8_LDA
#undef PG8_LDB
#undef PG8_MMA
#undef PG8_WAIT_V
#undef PG8_WAIT_L
#undef PG8_BAR
#undef PG8_SCHED
}
}
#define LAS __attribute__((address_space(3)))
typedef unsigned short bf16;
typedef short bf16x8 __attribute__((ext_vector_type(8)));
typedef short s16x4 __attribute__((ext_vector_type(4)));
typedef float f32x4 __attribute__((ext_vector_type(4)));
typedef unsigned u32x2 __attribute__((ext_vector_type(2)));
typedef unsigned u32x4 __attribute__((ext_vector_type(4)));

constexpr int DM = 1024, NBATCH = 16, SEQ = 4096, DEPTH = 4, CTXL = 256, FF = 4096;
constexpr int ML = NBATCH * SEQ, MCX = NBATCH * CTXL, MT = ML + MCX;
constexpr int NP = 2816, NINP = 3072, NSM = 48, NINSRC = 2864;
constexpr float EPS = 1e-6f;
constexpr int NT = 512, NWAVES = 8;
constexpr int LDS_BYTES = 147456;
constexpr int LT = 72;
constexpr int TB = 64 * LT * 2;
constexpr int NGRP = 17;
constexpr int MST_TILE = 65 * 64;

constexpr size_t MiB = 1u << 20;
constexpr size_t WS_WIN = 0, WS_WOUT = 24 * MiB, WS_W1 = 32 * MiB, WS_W2 = 64 * MiB, WS_MOD = 96 * MiB, WS_SM = 98 * MiB, WS_XC = 112 * MiB,
                 WS_H = 128 * MiB, WS_P = 264 * MiB, WS_MST = 638 * MiB, WS_GST = 778 * MiB, WS_MSC = 914 * MiB, WS_GDEC = 915 * MiB, WS_PART = 920 * MiB, WS_END = 984 * MiB;
constexpr size_t WS_HID = WS_P;
constexpr size_t WS_BAR = WS_MSC + 512 * 1024;
static_assert(WS_HID + (size_t)MT * FF * 2 <= WS_MSC, "hidden overlay");
static_assert(WS_P + (size_t)MT * NP * 2 <= WS_MST && WS_MST + (size_t)512 * NGRP * MST_TILE * 4 <= WS_GST && WS_GST + (size_t)512 * NGRP * 4096 * 4 <= WS_MSC, "ws map");

__device__ __forceinline__ unsigned f2bf(float f) { unsigned u = __builtin_bit_cast(unsigned, f); return (u + 0x7fffu + ((u >> 16) & 1u)) >> 16; }
__device__ __forceinline__ unsigned pk2(float lo, float hi) { return pg8::cvt_pk_bf16(lo, hi); }
__device__ __forceinline__ float bf2f(bf16 v) { return __builtin_bit_cast(float, ((unsigned)v) << 16); }
__device__ __forceinline__ float bfs2f(short v) { return __builtin_bit_cast(float, ((unsigned)(unsigned short)v) << 16); }
__device__ __forceinline__ float fexp(float x) { return __builtin_amdgcn_exp2f(x * 1.4426950408889634f); }
__device__ __forceinline__ float logsigmoidf(float x) { return fminf(x, 0.f) - log1pf(expf(-fabsf(x))); }
__device__ __forceinline__ float sigmoidf_(float x) { return __builtin_amdgcn_rcpf(1.f + fexp(-x)); }
__device__ __forceinline__ float logsigmoid_fast(float x) { return -0.6931471805599453f * __builtin_amdgcn_logf(1.f + fexp(-x)); }
__device__ __forceinline__ float wave_sum(float v) {
#pragma unroll
    for (int o = 1; o < 64; o <<= 1) v += __shfl_xor(v, o);
    return v;
}
__device__ __forceinline__ float wave_max(float v) {
#pragma unroll
    for (int o = 1; o < 64; o <<= 1) v = fmaxf(v, __shfl_xor(v, o));
    return v;
}
#define LBAR() do { asm volatile("s_waitcnt lgkmcnt(0)" ::: "memory"); __builtin_amdgcn_s_barrier(); asm volatile("" ::: "memory"); } while (0)
#define MFMA16(a, b, c) __builtin_amdgcn_mfma_f32_16x16x32_bf16((a), (b), (c), 0, 0, 0)

__device__ __forceinline__ int in_srccol(int j) {
    if (j < 1792) return j;
    if (j < 2816) return j + 16;
    if (j < 2832) return j - 1024;
    if (j < 2864) return j;
    return -1;
}

struct EpiIn {
    static constexpr bool PERM = false, AFTER_DRAIN = false;
    bf16* P; float* SM; const float* mib; const float* mfb; const LAS float* rope;
    __device__ __forceinline__ void operator()(const f32x4 (&acc)[2][2][4][2], const pg8::Unit& u, int wr, int wc, int fr, int fq) const {
        const int pn = u.pn; const bool latent = u.pm < 256;
        const int rowb = u.pm * 256 + wr * 64 + fr;
        if (pn == 11) {
            if (wc < 2) {
#pragma unroll
                for (int ai = 0; ai < 2; ++ai)
#pragma unroll
                    for (int m = 0; m < 4; ++m) { const int row = rowb + ai * 128 + m * 16;
#pragma unroll
                        for (int n = 0; n < 2; ++n) { const int c = wc * 32 + n * 16 + 4 * fq;
                            if (c < 48) { f32x4 v = acc[ai][0][m][n];
                                if (c < 8) { v += *(const f32x4*)(mib + c); }
                                else if (c < 16) { v += *(const f32x4*)(mfb + c - 8); v[0] = logsigmoidf(v[0]); v[1] = logsigmoidf(v[1]); v[2] = logsigmoidf(v[2]); v[3] = logsigmoidf(v[3]); }
                                *(f32x4*)(SM + (size_t)row * NSM + c) = v; } } }
            }
            return;
        }
        int op = 0;
        if (pn < 2) op = 1; else if (pn == 2) op = 2; else if (pn == 4 || pn == 7) op = 3; else if (pn == 6) op = 4; else if (pn == 10) op = 5;
        const float sc = op == 1 ? 0.125f * 1.4426950408889634f : (op == 3 ? 0.125f : 1.f);
        const bool dorope = latent && (op == 1 || op == 2);
#pragma unroll
        for (int ai = 0; ai < 2; ++ai)
#pragma unroll
            for (int m = 0; m < 4; ++m) {
                const int row = rowb + ai * 128 + m * 16;
                f32x4 cs = {1.f, 1.f, 1.f, 1.f}, sn = {0.f, 0.f, 0.f, 0.f};
                if (dorope) { const int t = row & 4095; const int pos = (wc & 1) ? (t & 63) : (t >> 6);
                    cs = *(const LAS f32x4*)(rope + pos * 16 + 4 * fq); sn = *(const LAS f32x4*)(rope + 1024 + pos * 16 + 4 * fq); }
                bf16* rowp = P + (size_t)row * NP + pn * 256 + wc * 32 + 4 * fq;
#pragma unroll
                for (int bj = 0; bj < 2; ++bj) {
                    f32x4 x1 = acc[ai][bj][m][0], x2 = acc[ai][bj][m][1];
                    if (dorope && (op == 1 || bj == 0)) { const f32x4 o1 = x1 * cs - x2 * sn, o2 = x2 * cs + x1 * sn; x1 = o1; x2 = o2; }
                    x1 = x1 * sc; x2 = x2 * sc;
                    if (op == 4) {
#pragma unroll
                        for (int j = 0; j < 4; ++j) { x1[j] = sigmoidf_(x1[j]); x2[j] = sigmoidf_(x2[j]); } }
                    if (op == 5) {
#pragma unroll
                        for (int j = 0; j < 4; ++j) { x1[j] = x1[j] * sigmoidf_(x1[j]); x2[j] = x2[j] * sigmoidf_(x2[j]); } }
                    u32x2 w1, w2; w1.x = pk2(x1[0], x1[1]); w1.y = pk2(x1[2], x1[3]); w2.x = pk2(x2[0], x2[1]); w2.y = pk2(x2[2], x2[3]);
                    *(u32x2*)(rowp + bj * 128) = w1; *(u32x2*)(rowp + bj * 128 + 16) = w2;
                }
                asm volatile("" ::: "memory");
            }
    }
};

struct EpiRes {
    static constexpr bool PERM = false, AFTER_DRAIN = false;
    const float* srcL; const float* srcC; float* dstL; float* dstC; const float* gate;
    int nt_full; float* part;
    __device__ __forceinline__ void operator()(const f32x4 (&acc)[2][2][4][2], const pg8::Unit& u, int wr, int wc, int fr, int fq) const {
        const bool latent = u.pm < 256; const bool split = u.nt < nt_full;
        const int b = latent ? (u.pm >> 4) : 16;
        const float* src = latent ? srcL + (size_t)u.pm * 256 * DM : srcC + (size_t)(u.pm - 256) * 256 * DM;
        float* dst = latent ? dstL + (size_t)u.pm * 256 * DM : dstC + (size_t)(u.pm - 256) * 256 * DM;
        const int col0 = u.pn * 256 + wc * 32 + 4 * fq;
        const float* g = gate + (size_t)b * 6144 + col0;
#pragma unroll
        for (int bj = 0; bj < 2; ++bj)
#pragma unroll
            for (int n = 0; n < 2; ++n) { const f32x4 gv = *(const f32x4*)(g + bj * 128 + n * 16);
#pragma unroll
                for (int ai = 0; ai < 2; ++ai) {
#pragma unroll
                    for (int m = 0; m < 4; ++m) { const size_t off = (size_t)(ai * 128 + wr * 64 + m * 16 + fr) * DM + col0 + bj * 128 + n * 16;
                        if (split) { *(f32x4*)(part + (size_t)(u.kb / u.nt) * MCX * DM + (size_t)(u.pm - 256) * 256 * DM + off) = gv * acc[ai][bj][m][n]; }
                        else { const f32x4 sv = *(const f32x4*)(src + off);
                        *(f32x4*)(dst + off) = sv + gv * acc[ai][bj][m][n]; } } }
                asm volatile("" ::: "memory"); }
    }
};

struct EpiRelu2 {
    static constexpr bool PERM = true, AFTER_DRAIN = false;
    bf16* O;
    __device__ __forceinline__ void operator()(const f32x4 (&acc)[2][2][4][2], const pg8::Unit& u, int wr, int wc, int fr, int fq) const {
        const int row0 = u.pm * 256 + wr * 64 + fr, col0 = u.pn * 256 + wc * 32 + 8 * fq;
#pragma unroll
        for (int ai = 0; ai < 2; ++ai)
#pragma unroll
            for (int m = 0; m < 4; ++m) { bf16* rowp = O + (size_t)(row0 + ai * 128 + m * 16) * FF + col0;
#pragma unroll
                for (int bj = 0; bj < 2; ++bj) { f32x4 v0 = acc[ai][bj][m][0], v1 = acc[ai][bj][m][1];
#pragma unroll
                    for (int j = 0; j < 4; ++j) { const float a = fmaxf(v0[j], 0.f), c = fmaxf(v1[j], 0.f); v0[j] = a * a; v1[j] = c * c; }
                    u32x4 w; w.x = pk2(v0[0], v0[1]); w.y = pk2(v0[2], v0[3]); w.z = pk2(v1[0], v1[1]); w.w = pk2(v1[2], v1[3]);
                    *(u32x4*)(rowp + bj * 128) = w; } }
    }
};

struct SplitOrder : pg8::StaticOrder {
    __device__ bool next(int i, pg8::Unit& u) const {
        const long L = (long)i * G + c;
        if (L < 1024) return pg8::StaticOrder::next(i, u);
        const int r = (int)(L - 1024); if (r >= 256) return false;
        u.pm = 256 + (r >> 4); u.pn = (r >> 2) & 3; u.kb = (r & 3) * (ntf / 4); u.nt = ntf / 4; return true;
    }
};

struct Args { const float* in[20]; float* out; unsigned char* ws; };

struct Ctx {
    LAS unsigned char* lds; int tid, lane, wave, G, bid;
    const float* const* in;
    float* out; unsigned char* ws;
};

__device__ __forceinline__ void transpose_item(const float* W, int K, int N, bf16* WT, int Ndst, bool inmap, LAS float* scr, int item, int lane) {
    const int nblk = Ndst / 64, kb = item / nblk, nb = item % nblk, k0 = 64 * kb, n0 = 64 * nb;
    const int c4 = (lane & 15) * 4, rr = lane >> 4;
    int scol = n0 + c4; bool vec = true;
    if (inmap) { scol = in_srccol(n0 + c4); vec = (scol >= 0) && (in_srccol(n0 + c4 + 3) == scol + 3); }
#pragma unroll 8
    for (int i = 0; i < 16; ++i) { const int kk = 4 * i + rr; f32x4 v = {0.f, 0.f, 0.f, 0.f};
        if (vec) v = *(const f32x4*)(W + (size_t)(k0 + kk) * N + scol);
        else if (inmap) {
#pragma unroll
            for (int q = 0; q < 4; ++q) { const int sq = in_srccol(n0 + c4 + q); if (sq >= 0) v[q] = W[(size_t)(k0 + kk) * N + sq]; } }
        *(LAS f32x4*)(scr + kk * 68 + c4) = v; }
    asm volatile("s_waitcnt lgkmcnt(0)" ::: "memory");
    const int c = lane & 7;
#pragma unroll
    for (int j = 0; j < 8; ++j) { const int n = (lane >> 3) + 8 * j; const LAS float* sp = scr + (8 * c) * 68 + n;
        u32x4 o; o.x = pk2(sp[0 * 68], sp[1 * 68]); o.y = pk2(sp[2 * 68], sp[3 * 68]); o.z = pk2(sp[4 * 68], sp[5 * 68]); o.w = pk2(sp[6 * 68], sp[7 * 68]);
        *(u32x4*)(WT + (size_t)(n0 + n) * K + k0 + 8 * c) = o; }
    asm volatile("s_waitcnt lgkmcnt(0)" ::: "memory");
}

__device__ __forceinline__ void prologue(const Ctx& F) {
    {
        LAS float* sc = (LAS float*)F.lds;
        LAS float* red = (LAS float*)(F.lds + 1024 * 20 * 4);
        const float* c = F.in[1]; const float* cc = F.in[3];
        bool staged = false;
        for (int t = F.bid; t < 4 * 96; t += F.G) {
            if (!staged) {
                for (int i = F.tid; i < 17 * 1024; i += NT) { const float v = i < 16 * 1024 ? c[i] : cc[i - 16 * 1024]; sc[(i & 1023) * 20 + (i >> 10)] = v / (1.f + expf(-v)); }
                staged = true; __syncthreads();
            }
            const int l = t / 96, c0 = (t % 96) * 64;
            const float* W = F.in[4] + (size_t)l * DM * 6144;
            const int ks = F.tid >> 6, col = F.tid & 63;
            float acc[17];
#pragma unroll
            for (int b = 0; b < 17; ++b) acc[b] = 0.f;
#pragma unroll 8
            for (int k = ks * 128; k < ks * 128 + 128; ++k) { const float w = W[(size_t)k * 6144 + c0 + col];
                const f32x4 s0 = *(const LAS f32x4*)(sc + k * 20), s1 = *(const LAS f32x4*)(sc + k * 20 + 4), s2 = *(const LAS f32x4*)(sc + k * 20 + 8), s3 = *(const LAS f32x4*)(sc + k * 20 + 12);
                const float s16 = sc[k * 20 + 16];
#pragma unroll
                for (int q = 0; q < 4; ++q) { acc[q] += s0[q] * w; acc[4 + q] += s1[q] * w; acc[8 + q] += s2[q] * w; acc[12 + q] += s3[q] * w; }
                acc[16] += s16 * w; }
#pragma unroll
            for (int b = 0; b < 17; ++b) red[(ks * 17 + b) * 64 + col] = acc[b];
            __syncthreads();
            float* MOD = (float*)(F.ws + WS_MOD);
            for (int i = F.tid; i < 17 * 64; i += NT) { const int b = i >> 6, cl = i & 63; float s = F.in[5][(size_t)l * 6144 + c0 + cl];
#pragma unroll
                for (int k8 = 0; k8 < 8; ++k8) s += red[(k8 * 17 + b) * 64 + cl];
                MOD[((size_t)l * 17 + b) * 6144 + c0 + cl] = s; }
            __syncthreads();
        }
        __syncthreads();
    }
    {
        LAS float* scr = (LAS float*)(F.lds + F.wave * 17408);
        const int gw = F.bid * NWAVES + F.wave, NGW = F.G * NWAVES;
        constexpr int I_IN = (DM / 64) * (NINP / 64), I_O = (DM / 64) * (DM / 64), I_1 = (DM / 64) * (FF / 64), I_2 = (FF / 64) * (DM / 64);
        constexpr int PER_L = I_IN + I_O + I_1 + I_2;
        for (int it = gw; it < DEPTH * PER_L; it += NGW) {
            const int l = it / PER_L; int r = it % PER_L;
            if (r < I_IN) { transpose_item(F.in[8] + (size_t)l * DM * NINSRC, DM, NINSRC, (bf16*)(F.ws + WS_WIN) + (size_t)l * NINP * DM, NINP, true, scr, r, F.lane); continue; } r -= I_IN;
            if (r < I_O) { transpose_item(F.in[16] + (size_t)l * DM * DM, DM, DM, (bf16*)(F.ws + WS_WOUT) + (size_t)l * DM * DM, DM, false, scr, r, F.lane); continue; } r -= I_O;
            if (r < I_1) { transpose_item(F.in[17] + (size_t)l * DM * FF, DM, FF, (bf16*)(F.ws + WS_W1) + (size_t)l * FF * DM, FF, false, scr, r, F.lane); continue; } r -= I_1;
            transpose_item(F.in[18] + (size_t)l * FF * DM, FF, DM, (bf16*)(F.ws + WS_W2) + (size_t)l * DM * FF, DM, false, scr, r, F.lane);
        }
    }
}

__device__ __forceinline__ void norm_phase(const Ctx& F, const float* srcL, const float* srcC, const float* g, const float* mod  , int Meff, const float* part = nullptr, float* xcw = nullptr) {
    bf16* H = (bf16*)(F.ws + WS_H);
    constexpr int NR = 4;
    const int gw = F.bid * NWAVES + F.wave, NGW = F.G * NWAVES;
    for (int r = NR * gw; r < Meff; r += NR * NGW) {
        const bool latent = r < ML; const int b = latent ? (r >> 12) : 16;
        const float* xr = latent ? srcL + (size_t)r * DM : srcC + (size_t)(r - ML) * DM;
        const float* sh = mod + (size_t)b * 6144; const float* scl = sh + 1024;
        f32x4 v[NR][4];
#pragma unroll
        for (int q = 0; q < NR; ++q)
#pragma unroll
            for (int j = 0; j < 4; ++j) v[q][j] = *(const f32x4*)(xr + q * DM + 4 * F.lane + 256 * j);
        if (part && !latent) {
#pragma unroll
            for (int q = 0; q < NR; ++q)
#pragma unroll
                for (int j = 0; j < 4; ++j) { const size_t o = (size_t)(r + q - ML) * DM + 4 * F.lane + 256 * j;
                    v[q][j] = v[q][j] + ((*(const f32x4*)(part + o) + *(const f32x4*)(part + (size_t)MCX * DM + o)) + (*(const f32x4*)(part + (size_t)2 * MCX * DM + o) + *(const f32x4*)(part + (size_t)3 * MCX * DM + o)));
                    *(f32x4*)(xcw + o) = v[q][j]; }
        }
        float rstd[NR];
#pragma unroll
        for (int q = 0; q < NR; ++q) { float s = 0.f;
#pragma unroll
            for (int j = 0; j < 4; ++j) s += (v[q][j].x * v[q][j].x + v[q][j].y * v[q][j].y) + (v[q][j].z * v[q][j].z + v[q][j].w * v[q][j].w);
            rstd[q] = 1.f / sqrtf(wave_sum(s) * (1.f / DM) + EPS); }
#pragma unroll
        for (int j = 0; j < 4; ++j) { const int k = 4 * F.lane + 256 * j;
            const f32x4 gg = *(const f32x4*)(g + k), sc1 = *(const f32x4*)(scl + k), sh0 = *(const f32x4*)(sh + k);
            const f32x4 gs = gg * (sc1 + 1.f);
#pragma unroll
            for (int q = 0; q < NR; ++q) { const f32x4 o = v[q][j] * rstd[q] * gs + sh0;
                u32x2 w; w.x = pk2(o.x, o.y); w.y = pk2(o.z, o.w); *(u32x2*)(H + (size_t)(r + q) * DM + k) = w; } }
    }
}

__device__ __forceinline__ void final_norm(const Ctx& F) {
    const float* g = F.in[19];
    constexpr int NR = 4;
    const int gw = F.bid * NWAVES + F.wave, NGW = F.G * NWAVES;
    for (int r = NR * gw; r < ML; r += NR * NGW) {
        float* xr = F.out + (size_t)r * DM;
        f32x4 v[NR][4];
#pragma unroll
        for (int q = 0; q < NR; ++q)
#pragma unroll
            for (int j = 0; j < 4; ++j) v[q][j] = *(const f32x4*)(xr + q * DM + 4 * F.lane + 256 * j);
        float rstd[NR];
#pragma unroll
        for (int q = 0; q < NR; ++q) { float s = 0.f;
#pragma unroll
            for (int j = 0; j < 4; ++j) s += (v[q][j].x * v[q][j].x + v[q][j].y * v[q][j].y) + (v[q][j].z * v[q][j].z + v[q][j].w * v[q][j].w);
            rstd[q] = 1.f / sqrtf(wave_sum(s) * (1.f / DM) + EPS); }
#pragma unroll
        for (int j = 0; j < 4; ++j) { const int k = 4 * F.lane + 256 * j; const f32x4 gg = *(const f32x4*)(g + k);
#pragma unroll
            for (int q = 0; q < NR; ++q) *(f32x4*)(xr + q * DM + k) = v[q][j] * rstd[q] * gg; }
    }
}
#define XB_TMO      128
#define XB_XCNT(j)  (256  + 64 * (j))
#define XB_XSUB(j)  (1280 + 64 * (j))
#define XB_XGEN(j)  (2304 + 64 * (j))
#define XB_TOP      3328
#define XB_TOPGEN   3392
#define XCD_BAR_WORDS 3456
#define XB_SPIN_CAP (1u << 18)

__device__ __forceinline__ unsigned xb_ld(unsigned* p)              { return __hip_atomic_load(p, __ATOMIC_RELAXED, __HIP_MEMORY_SCOPE_AGENT); }
__device__ __forceinline__ unsigned xb_add(unsigned* p, unsigned v) { return __hip_atomic_fetch_add(p, v, __ATOMIC_RELAXED, __HIP_MEMORY_SCOPE_AGENT); }
__device__ __forceinline__ unsigned xb_xcc_id() { return (unsigned)__builtin_amdgcn_s_getreg((3 << 11) | 20) & 0xFu; }
#define XB_SPIN(cond, bar) do { unsigned _sp = 0; while (cond) { __builtin_amdgcn_s_sleep(1); \
    if ((++_sp & 255u) == 0u) { if (xb_ld(&(bar)[XB_TMO])) break; if (_sp > XB_SPIN_CAP) { atomicAdd(&(bar)[XB_TMO], 1u); break; } } } } while (0)

struct XcdBarrier {
    unsigned* bar; unsigned x;
    volatile LAS unsigned* st;
};

__device__ __forceinline__ XcdBarrier xcd_barrier_post(unsigned* bar, volatile LAS unsigned* st) {
    XcdBarrier b; b.bar = bar; b.x = xb_xcc_id(); b.st = st;
    if (threadIdx.x == 0) (void)xb_add(&bar[XB_XCNT(b.x)], 1u);
    return b;
}
__device__ __forceinline__ void xcd_barrier_complete(unsigned* bar, unsigned x, unsigned& nloc, unsigned& nx) {
    const unsigned G = gridDim.x * gridDim.y * gridDim.z;
    unsigned sum, cnt, mine, sp = 0u;
    for (;;) {
        sum = 0u; cnt = 0u; mine = 0u;
#pragma unroll
        for (unsigned j = 0; j < 16; ++j) { const unsigned c = xb_ld(&bar[XB_XCNT(j)]); sum += c; cnt += (c > 0u) ? 1u : 0u; mine = (j == x) ? c : mine; }
        if (sum == G) break;
        __builtin_amdgcn_s_sleep(1);
        if ((++sp & 255u) == 0u) { if (xb_ld(&bar[XB_TMO])) break; if (sp > XB_SPIN_CAP) { atomicAdd(&bar[XB_TMO], 1u); break; } }
    }
    nloc = mine > 0u ? mine : 1u; nx = cnt > 0u ? cnt : 1u;
}

__device__ __forceinline__ void xcd_barrier(const XcdBarrier& b) {
    asm volatile("s_waitcnt vmcnt(0)" ::: "memory");
    __syncthreads();
    if (threadIdx.x == 0) {
        unsigned* bar = b.bar;
        __builtin_amdgcn_s_waitcnt(0);
        unsigned nloc = b.st[0], nx = b.st[1];
        if (nloc == 0u) { xcd_barrier_complete(bar, b.x, nloc, nx); b.st[0] = nloc; b.st[1] = nx; }
        const unsigned old = xb_add(&bar[XB_XSUB(b.x)], 1u);
        const unsigned gen = old / nloc;
        if (old + 1u == (gen + 1u) * nloc) {
            __builtin_amdgcn_fence(__ATOMIC_RELEASE, "agent");
            asm volatile("s_waitcnt vmcnt(0)" ::: "memory");
            const unsigned og = xb_add(&bar[XB_TOP], 1u);
            const unsigned tg = og / nx;
            if (og + 1u == (tg + 1u) * nx) xb_add(&bar[XB_TOPGEN], 1u);
            else XB_SPIN(xb_ld(&bar[XB_TOPGEN]) == tg, bar);
            __builtin_amdgcn_fence(__ATOMIC_ACQUIRE, "agent");
            xb_add(&bar[XB_XGEN(b.x)], 1u);
            asm volatile("s_waitcnt vmcnt(0)" ::: "memory");
        } else {
            XB_SPIN(xb_ld(&bar[XB_XGEN(b.x)]) == gen, bar);
            __builtin_amdgcn_fence(__ATOMIC_ACQUIRE, "agent");
            asm volatile("s_waitcnt vmcnt(0)" ::: "memory");
        }
    }
    __syncthreads();
}
constexpr int NATT_LAT = NBATCH * 2 * 32, NATT_CTX = NBATCH * 2 * 2;
__device__ __forceinline__ void attn_task(const Ctx& F, int t, const bf16* P, bf16* MIX, const float* sink) {
    int tid_ = F.tid; asm volatile("" : "+v"(tid_)); const int tid = tid_, wave = __builtin_amdgcn_readfirstlane(tid_ >> 6), lane = tid_ & 63, quad = lane >> 4, l15 = lane & 15;
    bool lat; int b, g, qb;
    if (t < NATT_LAT) { lat = true; b = t >> 6; g = (t >> 5) & 1; qb = t & 31; } else { lat = false; const int u = t - NATT_LAT; b = u >> 2; g = (u >> 1) & 1; qb = u & 1; }
    const int qrow0 = (lat ? b * SEQ : ML + b * CTXL) + qb * 128 + (wave & 1) * 64;
    const int hq = g * 4 + (wave >> 1);
    LAS bf16* Ks = (LAS bf16*)F.lds; LAS bf16* VsT = (LAS bf16*)(F.lds + TB);
    bf16x8 qf[4][2];
#pragma unroll
    for (int nb = 0; nb < 4; ++nb)
#pragma unroll
        for (int ks = 0; ks < 2; ++ks) qf[nb][ks] = *(const bf16x8*)(P + (size_t)(qrow0 + nb * 16 + l15) * NP + hq * 64 + ks * 32 + 8 * quad);
    const float sk = sink[hq] * 1.4426950408889634f;
    float m_[4], l_[4];
#pragma unroll
    for (int nb = 0; nb < 4; ++nb) { m_[nb] = sk; l_[nb] = (quad == 0) ? 1.f : 0.f; }
    f32x4 ot[4][4];
#pragma unroll
    for (int d = 0; d < 4; ++d)
#pragma unroll
        for (int nb = 0; nb < 4; ++nb) ot[d][nb] = (f32x4){0.f, 0.f, 0.f, 0.f};
    const int t0 = lat ? (2 * qb - 2 < 0 ? 0 : 2 * qb - 2) : 0, t1 = lat ? (2 * qb + 3 > 63 ? 63 : 2 * qb + 3) : -1;
    const int nl = t1 - t0 + 1;
    const int sr = tid >> 3, sc8 = tid & 7;
    bf16x8 kv, vv;
    { const int krow0 = nl > 0 ? b * SEQ + t0 * 64 : ML + b * CTXL;
      kv = *(const bf16x8*)(P + (size_t)(krow0 + sr) * NP + 512 + g * 64 + sc8 * 8); vv = *(const bf16x8*)(P + (size_t)(krow0 + sr) * NP + 640 + g * 64 + sc8 * 8); }
    const int vpos = 32 * (sr >> 5) + 8 * ((sr >> 2) & 3) + 4 * ((sr >> 4) & 1) + (sr & 3);
    for (int it = 0; it < nl + 4; ++it) {
        const bool isloc = it < nl;
        LBAR();
        *(LAS bf16x8*)(Ks + sr * LT + sc8 * 8) = kv;
#pragma unroll
        for (int j = 0; j < 8; ++j) VsT[(sc8 * 8 + j) * LT + vpos] = (bf16)vv[j];
        if (it + 1 < nl + 4) { const int krow1 = (it + 1 < nl) ? b * SEQ + (t0 + it + 1) * 64 : ML + b * CTXL + (it + 1 - nl) * 64;
            kv = *(const bf16x8*)(P + (size_t)(krow1 + sr) * NP + 512 + g * 64 + sc8 * 8); vv = *(const bf16x8*)(P + (size_t)(krow1 + sr) * NP + 640 + g * 64 + sc8 * 8); }
        LBAR();
        const int kt0 = (t0 + it) * 64, q0w = qb * 128 + (wave & 1) * 64;
        if (isloc && (kt0 >= q0w + 192 || kt0 <= q0w - 192)) continue;
        const bool needmask = isloc && (kt0 > q0w + 65 || kt0 < q0w - 65);
        f32x4 st[4][4];
#pragma unroll
        for (int mb = 0; mb < 4; ++mb)
#pragma unroll
            for (int nb = 0; nb < 4; ++nb) st[mb][nb] = (f32x4){0.f, 0.f, 0.f, 0.f};
        {
            bf16x8 kfr[4][2];
#pragma unroll
            for (int mb = 0; mb < 4; ++mb)
#pragma unroll
                for (int ks = 0; ks < 2; ++ks) kfr[mb][ks] = *(const LAS bf16x8*)(Ks + (mb * 16 + l15) * LT + ks * 32 + 8 * quad);
#pragma unroll
            for (int mb = 0; mb < 4; ++mb)
#pragma unroll
                for (int ks = 0; ks < 2; ++ks)
#pragma unroll
                    for (int nb = 0; nb < 4; ++nb) st[mb][nb] = MFMA16(kfr[mb][ks], qf[nb][ks], st[mb][nb]);
        }

        if (needmask) { const int kbase = (t0 + it) * 64 + 4 * quad;
#pragma unroll
            for (int nb = 0; nb < 4; ++nb) { const int qpos = qb * 128 + (wave & 1) * 64 + nb * 16 + l15;
#pragma unroll
                for (int mb = 0; mb < 4; ++mb)
#pragma unroll
                    for (int i = 0; i < 4; ++i) { const int d = qpos - (kbase + mb * 16 + i); if (d > 128 || d < -128) st[mb][nb][i] = -INFINITY; } } }
#pragma unroll
        for (int nb = 0; nb < 4; ++nb) {
            float mx = -INFINITY;
#pragma unroll
            for (int mb = 0; mb < 4; ++mb) mx = fmaxf(mx, fmaxf(fmaxf(st[mb][nb][0], st[mb][nb][1]), fmaxf(st[mb][nb][2], st[mb][nb][3])));
            mx = fmaxf(mx, __shfl_xor(mx, 16)); mx = fmaxf(mx, __shfl_xor(mx, 32));
            const float mn = fmaxf(m_[nb], mx), alpha = __builtin_amdgcn_exp2f(m_[nb] - mn); m_[nb] = mn;
            float ls = 0.f;
#pragma unroll
            for (int mb = 0; mb < 4; ++mb)
#pragma unroll
                for (int i = 0; i < 4; ++i) { const float p = __builtin_amdgcn_exp2f(st[mb][nb][i] - mn); ls += p; st[mb][nb][i] = p; }
            l_[nb] = l_[nb] * alpha + ls;
#pragma unroll
            for (int d = 0; d < 4; ++d) ot[d][nb] = ot[d][nb] * alpha;
        }
        bf16x8 vfr[4][2];
#pragma unroll
        for (int d = 0; d < 4; ++d)
#pragma unroll
            for (int kk = 0; kk < 2; ++kk) vfr[d][kk] = *(const LAS bf16x8*)(VsT + (d * 16 + l15) * LT + 32 * kk + 8 * quad);
#pragma unroll
        for (int kk = 0; kk < 2; ++kk) {
            bf16x8 pb[4];
#pragma unroll
            for (int nb = 0; nb < 4; ++nb) { u32x4 w; w.x = pk2(st[2 * kk][nb][0], st[2 * kk][nb][1]); w.y = pk2(st[2 * kk][nb][2], st[2 * kk][nb][3]);
                w.z = pk2(st[2 * kk + 1][nb][0], st[2 * kk + 1][nb][1]); w.w = pk2(st[2 * kk + 1][nb][2], st[2 * kk + 1][nb][3]); pb[nb] = __builtin_bit_cast(bf16x8, w); }
#pragma unroll
            for (int d = 0; d < 4; ++d) {
#pragma unroll
                for (int nb = 0; nb < 4; ++nb) ot[d][nb] = MFMA16(vfr[d][kk], pb[nb], ot[d][nb]);
            }
        }
    }
#pragma unroll
    for (int nb = 0; nb < 4; ++nb) {
        float lt = l_[nb]; lt += __shfl_xor(lt, 16); lt += __shfl_xor(lt, 32);
        const float inv = 1.f / lt;
        bf16* rowp = MIX + (size_t)(qrow0 + nb * 16 + l15) * DM + hq * 64 + 4 * quad;
#pragma unroll
        for (int d = 0; d < 4; ++d) { const f32x4 o = ot[d][nb] * inv; u32x2 w; w.x = pk2(o[0], o[1]); w.y = pk2(o[2], o[3]); *(u32x2*)(rowp + d * 16) = w; }
    }
}

template <int KS>
__device__ __forceinline__ void mmT(const LAS bf16* A, int lda, const LAS bf16* Bt, int ldb, int wave, int lane, f32x4 (&acc)[2]) {
    const int mb = wave >> 1, nb0 = (wave & 1) * 2, l15 = lane & 15, quad = lane >> 4;
#pragma unroll
    for (int ks = 0; ks < KS; ++ks) {
        const bf16x8 a = *(const LAS bf16x8*)(A + (mb * 16 + l15) * lda + ks * 32 + quad * 8);
#pragma unroll
        for (int j = 0; j < 2; ++j) { const bf16x8 bb = *(const LAS bf16x8*)(Bt + ((nb0 + j) * 16 + l15) * ldb + ks * 32 + quad * 8); acc[j] = MFMA16(a, bb, acc[j]); }
    }
}
__device__ __forceinline__ float pre_sum(float x, int lane) {
#pragma unroll
    for (int o = 1; o < 64; o <<= 1) { const float t = __shfl_up(x, o); if (lane >= o) x += t; }
    return x;
}
__device__ __forceinline__ float pre_max(float x, int lane) {
#pragma unroll
    for (int o = 1; o < 64; o <<= 1) { const float t = __shfl_up(x, o); if (lane >= o) x = fmaxf(x, t); }
    return x;
}
__device__ __forceinline__ float suf_max(float x, int lane) {
#pragma unroll
    for (int o = 1; o < 64; o <<= 1) { const float t = __shfl_down(x, o); if (lane + o < 64) x = fmaxf(x, t); }
    return x;
}
__device__ __forceinline__ int grp_row0(int b, int grp) { return grp < 16 ? b * SEQ + grp * 256 : ML + b * CTXL; }

template <int KS>
__device__ __forceinline__ void mmS(const LAS bf16* A, int lda, const LAS bf16* Bt, int ldb, int wave, int lane, f32x4 (&acc)[2]) {
    const int mb = wave >> 1, nb0 = (wave & 1) * 2, l15 = lane & 15, quad = lane >> 4;
#pragma unroll
    for (int ks = 0; ks < KS; ++ks) {
        const bf16x8 a = *(const LAS bf16x8*)(A + (mb * 16 + l15) * lda + ks * 32 + quad * 8);
#pragma unroll
        for (int j = 0; j < 2; ++j) { const bf16x8 bb = *(const LAS bf16x8*)(Bt + ((nb0 + j) * 16 + l15) * ldb + ks * 32 + quad * 8); acc[j] = MFMA16(bb, a, acc[j]); }
    }
}
__device__ __forceinline__ u32x2 pack4(const f32x4 v) { u32x2 w; w.x = pk2(v[0], v[1]); w.y = pk2(v[2], v[3]); return w; }
__device__ __forceinline__ void tr_tile(const LAS bf16* Nn, LAS bf16* T, LAS bf16* Tw, const LAS float* w, int wave, int lane) {
    const int mb = wave >> 1, nb0 = (wave & 1) * 2, l15 = lane & 15, quad = lane >> 4, ks = mb >> 1;
    const int hit = (mb & 1) * 16 + l15 - quad * 8;
    bf16x8 e;
#pragma unroll
    for (int q = 0; q < 8; ++q) e[q] = (q == hit) ? (short)0x3F80 : (short)0;
#pragma unroll
    for (int j = 0; j < 2; ++j) {
        const bf16x8 bb = *(const LAS bf16x8*)(Nn + ((nb0 + j) * 16 + l15) * LT + ks * 32 + quad * 8);
        f32x4 z = {0.f, 0.f, 0.f, 0.f};
        z = MFMA16(bb, e, z);
        const int o = (mb * 16 + l15) * LT + (nb0 + j) * 16 + 4 * quad;
        if (T) { float one = 1.f; asm volatile("" : "+v"(one));
            *(LAS u32x2*)(T + o) = pack4(z * one); }
        if (Tw) { const f32x4 wv = *(const LAS f32x4*)(w + (nb0 + j) * 16 + 4 * quad); *(LAS u32x2*)(Tw + o) = pack4(z * wv); }
    }
}
__device__ __forceinline__ unsigned pk2n(float lo, float hi) { unsigned r; asm volatile("v_cvt_pk_bf16_f32 %0, %1, %2\n\ts_nop 1" : "=v"(r) : "v"(lo), "v"(hi)); return r; }
__device__ __forceinline__ bf16x8 pack8n(const f32x4 a, const f32x4 b) { u32x4 w; w.x = pk2n(a[0], a[1]); w.y = pk2n(a[2], a[3]); w.z = pk2n(b[0], b[1]); w.w = pk2n(b[2], b[3]); return __builtin_bit_cast(bf16x8, w); }
__device__ __forceinline__ bf16x8 ident_frag(int blk, int l15, int quad) {
    const int hit = (blk & 1) * 16 + l15 - quad * 8; bf16x8 e;
#pragma unroll
    for (int q = 0; q < 8; ++q) e[q] = (q == hit) ? (short)0x3F80 : (short)0;
    return e;
}
__device__ __forceinline__ void mlstm_a_task(const Ctx& F, int t, const bf16* P, const float* SM) {
    int tid_ = F.tid; asm volatile("" : "+v"(tid_)); const int tid = tid_, wave = __builtin_amdgcn_readfirstlane(tid_ >> 6), lane = tid_ & 63, quad = lane >> 4, l15 = lane & 15;
    const int b = t / 68, h = (t / 17) & 3, grp = t % 17;
    const int row0 = grp_row0(b, grp);
    const int mb = wave >> 1, nb0 = (wave & 1) * 2;
    LAS bf16* Kn = (LAS bf16*)F.lds; LAS bf16* Vn = (LAS bf16*)(F.lds + 4 * TB);
    LAS float* w256 = (LAS float*)(F.lds + 8 * TB); LAS float* tots = w256 + 512; LAS float* mxs = tots + 8;
    float* MST = (float*)(F.ws + WS_MST); float* MSC = (float*)(F.ws + WS_MSC);
    const int r = tid >> 3, c = tid & 7;
    bf16x8 kreg[4], vreg[4];
#pragma unroll
    for (int j = 0; j < 4; ++j) { const bf16* rp = P + (size_t)(row0 + j * 64 + r) * NP + h * 64 + c * 8; kreg[j] = *(const bf16x8*)(rp + 1024); vreg[j] = *(const bf16x8*)(rp + 1280); }
    const int dir = wave >> 2, jw = wave & 3;
    const float* smr = SM + (size_t)(row0 + jw * 64 + lane) * NSM;
    const float iv = smr[dir * 4 + h], f = smr[8 + dir * 4 + h];
    const float pre = pre_sum(f, lane), tot = __shfl(pre, 63);
    const float bs = dir == 0 ? pre : tot - pre + f;
    LBAR();
    if (lane == 0) tots[dir * 4 + jw] = tot;
#pragma unroll
    for (int j = 0; j < 4; ++j) { *(LAS bf16x8*)(Kn + j * 64 * LT + r * LT + c * 8) = kreg[j]; *(LAS bf16x8*)(Vn + j * 64 * LT + r * LT + c * 8) = vreg[j]; }
    LBAR();
    float after = 0.f, aG = 0.f;
#pragma unroll
    for (int j = 0; j < 4; ++j) { const float tj = tots[dir * 4 + j]; aG += tj; if (dir == 0 ? (j > jw) : (j < jw)) after += tj; }
    const float gg = (tot - bs) + after + iv;
    const float mx = wave_max(gg);
    if (lane == 0) mxs[dir * 4 + jw] = mx;
    LBAR();
    const float mG = fmaxf(fmaxf(mxs[dir * 4], mxs[dir * 4 + 1]), fmaxf(mxs[dir * 4 + 2], mxs[dir * 4 + 3]));
    w256[dir * 256 + jw * 64 + lane] = fexp(gg - mG);
    const int ch0 = (b * 4 + h) * 2;
    if (jw == 0 && lane == 0) { MSC[((size_t)(ch0 + dir) * NGRP + grp) * 2] = aG; MSC[((size_t)(ch0 + dir) * NGRP + grp) * 2 + 1] = mG; }
    LBAR();
    const bf16x8 ev = ident_frag(mb, l15, quad), ek0 = ident_frag(nb0, l15, quad), ek1 = ident_frag(nb0 + 1, l15, quad);
    const int ksv = mb >> 1, ksk = nb0 >> 1;
    f32x4 acc[2][2]; float nsum[2][2];
#pragma unroll
    for (int d2 = 0; d2 < 2; ++d2)
#pragma unroll
        for (int j2 = 0; j2 < 2; ++j2) { acc[d2][j2] = (f32x4){0.f, 0.f, 0.f, 0.f}; nsum[d2][j2] = 0.f; }
    const f32x4 zero4 = {0.f, 0.f, 0.f, 0.f};
    for (int j = 0; j < 4; ++j) {
        const LAS bf16* Kj = Kn + j * 64 * LT; const LAS bf16* Vj = Vn + j * 64 * LT;
#pragma unroll
        for (int hh = 0; hh < 2; ++hh) {
            const int sA = (2 * hh) * 16, sB = sA + 16;
            const f32x4 w0a = *(const LAS f32x4*)(w256 + j * 64 + sA + 4 * quad), w0b = *(const LAS f32x4*)(w256 + j * 64 + sB + 4 * quad);
            const f32x4 w1a = *(const LAS f32x4*)(w256 + 256 + j * 64 + sA + 4 * quad), w1b = *(const LAS f32x4*)(w256 + 256 + j * 64 + sB + 4 * quad);
            const f32x4 zva = MFMA16(*(const LAS bf16x8*)(Vj + (sA + l15) * LT + ksv * 32 + quad * 8), ev, zero4);
            const f32x4 zvb = MFMA16(*(const LAS bf16x8*)(Vj + (sB + l15) * LT + ksv * 32 + quad * 8), ev, zero4);
            const bf16x8 vf0 = pack8n(zva * w0a, zvb * w0b), vf1 = pack8n(zva * w1a, zvb * w1b);
#pragma unroll
            for (int j2 = 0; j2 < 2; ++j2) {
                const bf16x8 ek = j2 == 0 ? ek0 : ek1;
                const f32x4 zka = MFMA16(*(const LAS bf16x8*)(Kj + (sA + l15) * LT + ksk * 32 + quad * 8), ek, zero4);
                const f32x4 zkb = MFMA16(*(const LAS bf16x8*)(Kj + (sB + l15) * LT + ksk * 32 + quad * 8), ek, zero4);
                const f32x4 pa0 = zka * w0a, pb0 = zkb * w0b, pa1 = zka * w1a, pb1 = zkb * w1b;
                nsum[0][j2] += ((pa0[0] + pa0[1]) + (pa0[2] + pa0[3])) + ((pb0[0] + pb0[1]) + (pb0[2] + pb0[3]));
                nsum[1][j2] += ((pa1[0] + pa1[1]) + (pa1[2] + pa1[3])) + ((pb1[0] + pb1[1]) + (pb1[2] + pb1[3]));
                float one = 1.f; asm volatile("" : "+v"(one));
                const bf16x8 kf = pack8n(zka * one, zkb * one);
                acc[0][j2] = MFMA16(kf, vf0, acc[0][j2]);
                acc[1][j2] = MFMA16(kf, vf1, acc[1][j2]);
            }
        }
    }
#pragma unroll
    for (int d2 = 0; d2 < 2; ++d2) {
        float* dst = MST + ((size_t)(ch0 + d2) * NGRP + grp) * MST_TILE;
#pragma unroll
        for (int j2 = 0; j2 < 2; ++j2) {
            *(f32x4*)(dst + (mb * 16 + l15) * 64 + (nb0 + j2) * 16 + 4 * quad) = acc[d2][j2];
            float n = nsum[d2][j2]; n += __shfl_xor(n, 16); n += __shfl_xor(n, 32);
            if (mb == 0 && quad == 0) dst[4096 + (nb0 + j2) * 16 + l15] = n;
        }
    }
}

__device__ __forceinline__ void mlstm_c_task(const Ctx& F, int t, const bf16* P, const float* SM, bf16* MIX, const float* gn) {
    int tid_ = F.tid; asm volatile("" : "+v"(tid_)); const int tid = tid_, wave = __builtin_amdgcn_readfirstlane(tid_ >> 6), lane = tid_ & 63, quad = lane >> 4, l15 = lane & 15;
    const int b = t / 68, h = (t / 17) & 3, grp = t % 17;
    const int row0 = grp_row0(b, grp);
    const int mb = wave >> 1, nb0 = (wave & 1) * 2;
    const int rr = mb * 16 + l15;
    LAS bf16* Qn = (LAS bf16*)F.lds; LAS bf16* Kn = (LAS bf16*)(F.lds + TB); LAS bf16* Vn = (LAS bf16*)(F.lds + 2 * TB); LAS bf16* KT = (LAS bf16*)(F.lds + 3 * TB);
    LAS bf16* VT = (LAS bf16*)(F.lds + 4 * TB); LAS bf16* VTw = (LAS bf16*)(F.lds + 5 * TB); LAS bf16* Pd = (LAS bf16*)(F.lds + 6 * TB); LAS bf16* Cst = (LAS bf16*)(F.lds + 7 * TB);
    LAS bf16* stash = (LAS bf16*)(F.lds + 8 * TB);
    LAS float* fs = (LAS float*)(F.lds + 8 * TB + 32768);
    LAS float* nvec = fs, *psum = fs + 64, *nq_s = fs + 192, *ssq = fs + 256, *scalA = fs + 384, *GG = fs + 400;
    const float* MST = (const float*)(F.ws + WS_MST); const float* MPREV = (const float*)(F.ws + WS_MSC) + 512 * NGRP * 2;
    const int r = tid >> 3, c = tid & 7;
    const size_t base0 = (size_t)((b * 4 + h) * 2) * NGRP + grp, base1 = base0 + NGRP;
    const bool zst = grp == 16;
    f32x4 accC[2];
#pragma unroll
    for (int j = 0; j < 2; ++j) accC[j] = zst ? (f32x4){0.f, 0.f, 0.f, 0.f} : *(const f32x4*)(MST + base1 * MST_TILE + rr * 64 + (nb0 + j) * 16 + 4 * quad);
    float m = zst ? 0.f : MPREV[base1]; const float m0 = zst ? 0.f : MPREV[base0];
    float nv1 = 0.f, nv0 = 0.f; if (tid < 64 && !zst) { nv1 = MST[base1 * MST_TILE + 4096 + tid]; nv0 = MST[base0 * MST_TILE + 4096 + tid]; }
    const f32x4 gn0 = *(const f32x4*)(gn + h * 64 + nb0 * 16 + 4 * quad), gn1 = *(const f32x4*)(gn + h * 64 + (nb0 + 1) * 16 + 4 * quad);
#define MC_JC(idx) (((idx) < 4) ? (3 - ((idx) & 3)) : ((idx) & 3))
    bf16x8 pq, pk, pv_;
    { const int rows = row0 + MC_JC(0) * 64; const bf16* rp = P + (size_t)(rows + r) * NP + h * 64 + c * 8;
      pq = *(const bf16x8*)(rp + 768); pk = *(const bf16x8*)(rp + 1024); pv_ = *(const bf16x8*)(rp + 1280); }
    LBAR();
    {
        const int gdir = wave < 4 ? 1 : 0; const int grows = row0 + MC_JC(wave) * 64;
        const float* smr = SM + (size_t)(grows + lane) * NSM;
        const float iv = smr[gdir * 4 + h], f = smr[8 + gdir * 4 + h];
        const float pre = pre_sum(f, lane), tot = __shfl(pre, 63);
        const float bs = gdir == 0 ? pre : tot - pre + f;
        const float uu = iv - bs;
        const float cmv = gdir == 0 ? pre_max(uu, lane) : suf_max(uu, lane);
        const float gg = tot - bs + iv;
        const float mch = wave_max(gg);
        LAS float* g = GG + wave * 256;
        g[lane] = bs; g[64 + lane] = uu; g[128 + lane] = cmv; g[192 + lane] = fexp(gg - mch);
        if (lane == 0) { scalA[wave * 2] = tot; scalA[wave * 2 + 1] = mch; }
    }
    for (int idx = 0; idx < 8; ++idx) {
        const int dir = idx < 4 ? 1 : 0, step = idx & 3, jc = MC_JC(idx);
        const int rows = row0 + jc * 64;
        if (idx == 4) { m = m0;
#pragma unroll
            for (int j = 0; j < 2; ++j) accC[j] = zst ? (f32x4){0.f, 0.f, 0.f, 0.f} : *(const f32x4*)(MST + base0 * MST_TILE + rr * 64 + (nb0 + j) * 16 + 4 * quad); }
        LBAR();
        if (step == 0) {
            if (tid < 64) nvec[tid] = dir == 1 ? nv1 : nv0;
#pragma unroll
            for (int j = 0; j < 2; ++j) *(LAS u32x2*)(Cst + rr * LT + (nb0 + j) * 16 + 4 * quad) = pack4(accC[j]);
        }
        *(LAS bf16x8*)(Qn + r * LT + c * 8) = pq; *(LAS bf16x8*)(Kn + r * LT + c * 8) = pk; *(LAS bf16x8*)(Vn + r * LT + c * 8) = pv_;
        const LAS float* bs_s = GG + idx * 256, *u_s = bs_s + 64, *cm_s = bs_s + 128, *w_s = bs_s + 192; const LAS float* scal = scalA + idx * 2;
        if (idx + 1 < 8) { const int nrows = row0 + MC_JC(idx + 1) * 64; const bf16* rp = P + (size_t)(nrows + r) * NP + h * 64 + c * 8;
            pq = *(const bf16x8*)(rp + 768); pk = *(const bf16x8*)(rp + 1024); pv_ = *(const bf16x8*)(rp + 1280); }
        u32x2 gate[2] = {{0u, 0u}, {0u, 0u}};
        if (dir == 0) {
#pragma unroll
            for (int j = 0; j < 2; ++j) gate[j] = *(const u32x2*)(P + (size_t)(rows + rr) * NP + 1536 + h * 64 + (nb0 + j) * 16 + 4 * quad);
        }
        LBAR();
        tr_tile(Kn, KT, nullptr, nullptr, wave, lane);
        tr_tile(Vn, VT, VTw, w_s, wave, lane);
        const float mmr = fmaxf(m, cm_s[rr]);
        {
            f32x4 qk[2] = {{0.f, 0.f, 0.f, 0.f}, {0.f, 0.f, 0.f, 0.f}};
            mmS<2>(Qn, LT, Kn, LT, wave, lane, qk);
            float ps = 0.f;
#pragma unroll
            for (int j = 0; j < 2; ++j) { const int s0 = (nb0 + j) * 16 + 4 * quad; const f32x4 u4 = *(const LAS f32x4*)(u_s + s0); f32x4 p;
#pragma unroll
                for (int i = 0; i < 4; ++i) { const int ss = s0 + i; const bool ok = dir == 0 ? (ss <= rr) : (ss >= rr); p[i] = ok ? fexp(u4[i] - mmr) * qk[j][i] : 0.f; }
                const u32x2 pw = pack4(p); *(LAS u32x2*)(Pd + rr * LT + s0) = pw;
                ps += __builtin_bit_cast(float, pw.x << 16) + __builtin_bit_cast(float, pw.x & 0xffff0000u) + __builtin_bit_cast(float, pw.y << 16) + __builtin_bit_cast(float, pw.y & 0xffff0000u); }
            ps += __shfl_xor(ps, 16); ps += __shfl_xor(ps, 32);
            if (quad == 0) psum[(wave & 1) * 64 + rr] = ps;
        }
        if (tid >= 256) { const int r2 = (tid - 256) >> 2, part = tid & 3; float a = 0.f;
            const bf16x8 q0 = *(const LAS bf16x8*)(Qn + r2 * LT + part * 16), q1 = *(const LAS bf16x8*)(Qn + r2 * LT + part * 16 + 8);
#pragma unroll
            for (int e = 0; e < 8; ++e) a += nvec[part * 16 + e] * bfs2f(q0[e]) + nvec[part * 16 + 8 + e] * bfs2f(q1[e]);
            a += __shfl_xor(a, 1); a += __shfl_xor(a, 2);
            if (part == 0) nq_s[r2] = a; }
        LBAR();
        f32x4 hv[2];
        {
            f32x4 cq[2] = {{0.f, 0.f, 0.f, 0.f}, {0.f, 0.f, 0.f, 0.f}}, pv[2] = {{0.f, 0.f, 0.f, 0.f}, {0.f, 0.f, 0.f, 0.f}};
            mmS<2>(Qn, LT, Cst, LT, wave, lane, cq);
            mmS<2>(Pd, LT, VT, LT, wave, lane, pv);
            const float wi = fexp(m - mmr);
            const float den = wi * nq_s[rr] + psum[rr] + psum[64 + rr];
            const float hd = fmaxf(fabsf(den), fexp(-(bs_s[rr] + mmr))); const float inv = 1.f / hd;
            hv[0] = (cq[0] * wi + pv[0]) * inv; hv[1] = (cq[1] * wi + pv[1]) * inv;
        }
        LAS u32x2* sp = (LAS u32x2*)stash + ((jc * 8 + wave) * 2) * 64 + lane;
        if (dir == 1) { sp[0] = pack4(hv[0]); sp[64] = pack4(hv[1]); }
        else {
            float sq = 0.f;
#pragma unroll
            for (int j = 0; j < 2; ++j) { const u32x2 sv = sp[j * 64];
                hv[j][0] += __builtin_bit_cast(float, sv.x << 16); hv[j][1] += __builtin_bit_cast(float, sv.x & 0xffff0000u); hv[j][2] += __builtin_bit_cast(float, sv.y << 16); hv[j][3] += __builtin_bit_cast(float, sv.y & 0xffff0000u);
                sq += hv[j][0] * hv[j][0] + hv[j][1] * hv[j][1] + hv[j][2] * hv[j][2] + hv[j][3] * hv[j][3]; }
            sq += __shfl_xor(sq, 16); sq += __shfl_xor(sq, 32);
            if (quad == 0) ssq[(wave & 1) * 64 + rr] = sq;
            LBAR();
            const float rs = 1.f / sqrtf((ssq[rr] + ssq[64 + rr]) * (1.f / 64.f) + EPS);
#pragma unroll
            for (int j = 0; j < 2; ++j) { const f32x4 gnv = j == 0 ? gn0 : gn1; const u32x2 gt = gate[j];
                f32x4 o; o[0] = hv[j][0] * rs * gnv[0] * __builtin_bit_cast(float, gt.x << 16); o[1] = hv[j][1] * rs * gnv[1] * __builtin_bit_cast(float, gt.x & 0xffff0000u);
                o[2] = hv[j][2] * rs * gnv[2] * __builtin_bit_cast(float, gt.y << 16); o[3] = hv[j][3] * rs * gnv[3] * __builtin_bit_cast(float, gt.y & 0xffff0000u);
                *(u32x2*)(MIX + (size_t)(rows + rr) * DM + 512 + h * 64 + (nb0 + j) * 16 + 4 * quad) = pack4(o); }
        }
        if (step < 3) {
            const float a = scal[0], mch = scal[1];
            const float mnew = fmaxf(a + m, mch), so = fexp(a + m - mnew), sn = fexp(mch - mnew);
            f32x4 cc[2] = {{0.f, 0.f, 0.f, 0.f}, {0.f, 0.f, 0.f, 0.f}};
            mmS<2>(VTw, LT, KT, LT, wave, lane, cc);
            accC[0] = accC[0] * so + cc[0] * sn; accC[1] = accC[1] * so + cc[1] * sn;
            m = mnew;
            LBAR();
            if (tid < 256) { const int e = tid >> 2, part = tid & 3; float nn = 0.f;
                const bf16x8 k0 = *(const LAS bf16x8*)(KT + e * LT + part * 16), k1 = *(const LAS bf16x8*)(KT + e * LT + part * 16 + 8);
#pragma unroll
                for (int q = 0; q < 8; ++q) nn += w_s[part * 16 + q] * bfs2f(k0[q]) + w_s[part * 16 + 8 + q] * bfs2f(k1[q]);
                nn += __shfl_xor(nn, 1); nn += __shfl_xor(nn, 2);
                if (part == 0) nvec[e] = so * nvec[e] + sn * nn; }
#pragma unroll
            for (int j = 0; j < 2; ++j) *(LAS u32x2*)(Cst + rr * LT + (nb0 + j) * 16 + 4 * quad) = pack4(accC[j]);
        }
    }
#undef MC_JC
}

__device__ __forceinline__ float gla_glog(const LAS float* gr, const float (&wa)[16], float ba) {
    float z = ba;
#pragma unroll
    for (int q = 0; q < 4; ++q) { const f32x4 g4 = *(const LAS f32x4*)(gr + 4 * q); z += g4[0] * wa[4 * q] + g4[1] * wa[4 * q + 1] + g4[2] * wa[4 * q + 2] + g4[3] * wa[4 * q + 3]; }
    return logsigmoid_fast(z) * (1.f / 16.f);
}
__device__ __forceinline__ void gla_a_task(const Ctx& F, int t, const bf16* P, const float* SM, const float* wa2, const float* gba) {
    int tid_ = F.tid; asm volatile("" : "+v"(tid_)); const int tid = tid_, wave = __builtin_amdgcn_readfirstlane(tid_ >> 6), lane = tid_ & 63, quad = lane >> 4, l15 = lane & 15;
    const int b = t / 68, h = (t / 17) & 3, grp = t % 17;
    const int row0 = grp_row0(b, grp);
    const int mb = wave >> 1, nb0 = (wave & 1) * 2;
    LAS bf16* Vn = (LAS bf16*)F.lds; LAS bf16* KKn0 = (LAS bf16*)(F.lds + TB); LAS bf16* KKn1 = (LAS bf16*)(F.lds + 2 * TB);
    LAS float* gl = (LAS float*)(F.lds + 3 * TB);
    LAS float* glr_s = (LAS float*)(F.lds + 3 * TB + 32768);
    LAS float* tot_s = (LAS float*)(F.lds + 3 * TB + 32768 + 8192);
    LAS float* segtot = tot_s + 128;
    float* GST = (float*)(F.ws + WS_GST); float* GDEC = (float*)(F.ws + WS_GDEC);
    const int gd = tid & 63, gdir = (tid >> 6) & 1, sg = tid >> 7;
    float wa[16];
#pragma unroll
    for (int q = 0; q < 16; ++q) wa[q] = wa2[(size_t)(gdir * 16 + q) * 256 + h * 64 + gd];
    const float ba = gba[gdir * 256 + h * 64 + gd];
    f32x4 acc0[2] = {{0.f, 0.f, 0.f, 0.f}, {0.f, 0.f, 0.f, 0.f}}, acc1[2] = {{0.f, 0.f, 0.f, 0.f}, {0.f, 0.f, 0.f, 0.f}};
    f32x4 R0[2] = {{1.f, 1.f, 1.f, 1.f}, {1.f, 1.f, 1.f, 1.f}}, R1[2] = {{1.f, 1.f, 1.f, 1.f}, {1.f, 1.f, 1.f, 1.f}};
    const bf16x8 ev = ident_frag(mb, l15, quad), ek0 = ident_frag(nb0, l15, quad), ek1 = ident_frag(nb0 + 1, l15, quad);
    const int ksv = mb >> 1, ksk = nb0 >> 1;
    const f32x4 zero4 = {0.f, 0.f, 0.f, 0.f};
    const int r = tid >> 3, c = tid & 7;
    bf16x8 pk, pv_; f32x4 pg;
    { const int rows = row0 + 3 * 64; const bf16* rp = P + (size_t)(rows + r) * NP + h * 64 + c * 8; pk = *(const bf16x8*)(rp + 2048); pv_ = *(const bf16x8*)(rp + 2304);
      pg = *(const f32x4*)(SM + (size_t)(rows + r) * NSM + 16 + c * 4); }
    for (int jj = 0; jj < 4; ++jj) {
        LBAR();
        const bf16x8 kreg = pk;
        *(LAS bf16x8*)(Vn + r * LT + c * 8) = pv_;
        *(LAS f32x4*)(glr_s + r * 32 + c * 4) = pg;
        if (jj + 1 < 4) { const int nrows = row0 + (2 - jj) * 64; const bf16* rp = P + (size_t)(nrows + r) * NP + h * 64 + c * 8; pk = *(const bf16x8*)(rp + 2048); pv_ = *(const bf16x8*)(rp + 2304);
            pg = *(const f32x4*)(SM + (size_t)(nrows + r) * NSM + 16 + c * 4); }
        LBAR();
        {
            float gv[16];
#pragma unroll
            for (int i = 0; i < 16; ++i) gv[i] = gla_glog(glr_s + (sg * 16 + i) * 32 + gdir * 16, wa, ba);
            float run = 0.f;
            if (gdir == 0) {
#pragma unroll
                for (int i = 15; i >= 0; --i) { const float tv = gv[i]; gv[i] = run; run += tv; }
            } else {
#pragma unroll
                for (int i = 0; i < 16; ++i) { const float tv = gv[i]; gv[i] = run; run += tv; }
            }
            segtot[(gdir * 4 + sg) * 64 + gd] = run;
            LBAR();
            float off = 0.f, all = 0.f;
#pragma unroll
            for (int q = 0; q < 4; ++q) { const float tq = segtot[(gdir * 4 + q) * 64 + gd]; all += tq; if (gdir == 0 ? (q > sg) : (q < sg)) off += tq; }
#pragma unroll
            for (int i = 0; i < 16; ++i) gl[(gdir * 64 + sg * 16 + i) * 64 + gd] = gv[i] + off;
            if (sg == 0) tot_s[gdir * 64 + gd] = all;
        }
        LBAR();
        {
            const f32x4 a0 = *(const LAS f32x4*)(gl + r * 64 + c * 8), a1 = *(const LAS f32x4*)(gl + r * 64 + c * 8 + 4);
            const f32x4 b0 = *(const LAS f32x4*)(gl + (64 + r) * 64 + c * 8), b1 = *(const LAS f32x4*)(gl + (64 + r) * 64 + c * 8 + 4);
            float k0[8], k1[8];
#pragma unroll
            for (int i = 0; i < 8; ++i) { const float kv = bfs2f(kreg[i]); k0[i] = kv * fexp(i < 4 ? a0[i] : a1[i - 4]); k1[i] = kv * fexp(i < 4 ? b0[i] : b1[i - 4]); }
            u32x4 w;
            w.x = pk2(k0[0], k0[1]); w.y = pk2(k0[2], k0[3]); w.z = pk2(k0[4], k0[5]); w.w = pk2(k0[6], k0[7]); *(LAS u32x4*)(KKn0 + r * LT + c * 8) = w;
            w.x = pk2(k1[0], k1[1]); w.y = pk2(k1[2], k1[3]); w.z = pk2(k1[4], k1[5]); w.w = pk2(k1[6], k1[7]); *(LAS u32x4*)(KKn1 + r * LT + c * 8) = w;
        }
        LBAR();
        f32x4 t0[2] = {{0.f, 0.f, 0.f, 0.f}, {0.f, 0.f, 0.f, 0.f}}, t1[2] = {{0.f, 0.f, 0.f, 0.f}, {0.f, 0.f, 0.f, 0.f}};
        float one = 1.f; asm volatile("" : "+v"(one));
#pragma unroll
        for (int hh = 0; hh < 2; ++hh) {
            const int sA = (2 * hh) * 16, sB = sA + 16;
            const f32x4 zva = MFMA16(*(const LAS bf16x8*)(Vn + (sA + l15) * LT + ksv * 32 + quad * 8), ev, zero4);
            const f32x4 zvb = MFMA16(*(const LAS bf16x8*)(Vn + (sB + l15) * LT + ksv * 32 + quad * 8), ev, zero4);
            const bf16x8 vf = pack8n(zva * one, zvb * one);
#pragma unroll
            for (int j2 = 0; j2 < 2; ++j2) {
                const bf16x8 ek = j2 == 0 ? ek0 : ek1;
                const f32x4 za0 = MFMA16(*(const LAS bf16x8*)(KKn0 + (sA + l15) * LT + ksk * 32 + quad * 8), ek, zero4);
                const f32x4 zb0 = MFMA16(*(const LAS bf16x8*)(KKn0 + (sB + l15) * LT + ksk * 32 + quad * 8), ek, zero4);
                const f32x4 za1 = MFMA16(*(const LAS bf16x8*)(KKn1 + (sA + l15) * LT + ksk * 32 + quad * 8), ek, zero4);
                const f32x4 zb1 = MFMA16(*(const LAS bf16x8*)(KKn1 + (sB + l15) * LT + ksk * 32 + quad * 8), ek, zero4);
                const bf16x8 kf0 = pack8n(za0 * one, zb0 * one), kf1 = pack8n(za1 * one, zb1 * one);
                t0[j2] = MFMA16(kf0, vf, t0[j2]);
                t1[j2] = MFMA16(kf1, vf, t1[j2]);
            }
        }
#pragma unroll
        for (int j = 0; j < 2; ++j) { const f32x4 tt0 = *(const LAS f32x4*)(tot_s + (nb0 + j) * 16 + 4 * quad), tt1 = *(const LAS f32x4*)(tot_s + 64 + (nb0 + j) * 16 + 4 * quad);
            f32x4 e0, e1;
#pragma unroll
            for (int i = 0; i < 4; ++i) { e0[i] = fexp(tt0[i]); e1[i] = fexp(tt1[i]); }
            acc0[j] = acc0[j] + t0[j] * R0[j]; R0[j] = R0[j] * e0;
            acc1[j] = acc1[j] * e1 + t1[j]; R1[j] = R1[j] * e1; }
    }
    const size_t base0 = (size_t)((b * 4 + h) * 2) * NGRP + grp, base1 = base0 + NGRP;
#pragma unroll
    for (int j = 0; j < 2; ++j) { const int dk = (nb0 + j) * 16 + 4 * quad; const int dv = mb * 16 + l15;
        *(f32x4*)(GST + base0 * 4096 + dv * 64 + dk) = acc0[j]; *(f32x4*)(GST + base1 * 4096 + dv * 64 + dk) = acc1[j];
        if (mb == 0 && l15 == 0) { *(f32x4*)(GDEC + base0 * 64 + dk) = R0[j]; *(f32x4*)(GDEC + base1 * 64 + dk) = R1[j]; } }
}

__device__ __forceinline__ void gla_c_task(const Ctx& F, int t, const bf16* P, const float* SM, bf16* MIX, const float* wa2, const float* gba, const float* gn) {
    int tid_ = F.tid; asm volatile("" : "+v"(tid_)); const int tid = tid_, wave = __builtin_amdgcn_readfirstlane(tid_ >> 6), lane = tid_ & 63, quad = lane >> 4, l15 = lane & 15;
    const int b = t / 68, h = (t / 17) & 3, grp = t % 17;
    const int row0 = grp_row0(b, grp);
    const int mb = wave >> 1, nb0 = (wave & 1) * 2;
    const int rr = mb * 16 + l15;
    LAS bf16* Qd = (LAS bf16*)F.lds; LAS bf16* Kd = (LAS bf16*)(F.lds + TB); LAS bf16* KKn = (LAS bf16*)(F.lds + 2 * TB); LAS bf16* KKT = (LAS bf16*)(F.lds + 3 * TB);
    LAS bf16* Vn = (LAS bf16*)(F.lds + 4 * TB); LAS bf16* VT = (LAS bf16*)(F.lds + 5 * TB); LAS bf16* Att = (LAS bf16*)(F.lds + 6 * TB); LAS bf16* ST = (LAS bf16*)(F.lds + 7 * TB);
    LAS float* gl = (LAS float*)(F.lds + 8 * TB);
    LAS float* glr_s = (LAS float*)(F.lds + 8 * TB + 16384);
    LAS bf16* stash = (LAS bf16*)(F.lds + 8 * TB + 16384 + 4096);
    LAS float* ssq = (LAS float*)(F.lds + 8 * TB + 16384 + 4096 + 32768);
    LAS float* bend = ssq + 128;
    LAS float* segtot = bend + 64;
    const float* GST = (const float*)(F.ws + WS_GST);
    const int gd = tid & 63, sg = tid >> 6;
    const int r = tid >> 3, c = tid & 7;
    const size_t base0 = (size_t)((b * 4 + h) * 2) * NGRP + grp, base1 = base0 + NGRP;
    const bool zst = grp == 16;
    f32x4 accS[2];
#pragma unroll
    for (int j = 0; j < 2; ++j) accS[j] = zst ? (f32x4){0.f, 0.f, 0.f, 0.f} : *(const f32x4*)(GST + base1 * 4096 + rr * 64 + (nb0 + j) * 16 + 4 * quad);
    float wa[16];
#pragma unroll
    for (int q = 0; q < 16; ++q) wa[q] = wa2[(size_t)(16 + q) * 256 + h * 64 + gd];
    float ba = gba[256 + h * 64 + gd];
    const f32x4 gn0 = *(const f32x4*)(gn + h * 64 + nb0 * 16 + 4 * quad), gn1 = *(const f32x4*)(gn + h * 64 + (nb0 + 1) * 16 + 4 * quad);
#define GC_JC(idx) (((idx) < 4) ? (3 - ((idx) & 3)) : ((idx) & 3))
    bf16x8 pq, pk, pv_; f32x4 pg = {0.f, 0.f, 0.f, 0.f};
    { const int rows = row0 + GC_JC(0) * 64; const bf16* rp = P + (size_t)(rows + r) * NP + h * 64 + c * 8;
      pq = *(const bf16x8*)(rp + 1792); pk = *(const bf16x8*)(rp + 2048); pv_ = *(const bf16x8*)(rp + 2304);
      if (tid < 256) pg = *(const f32x4*)(SM + (size_t)(rows + (tid >> 2)) * NSM + 16 + 16 + (tid & 3) * 4); }
    for (int idx = 0; idx < 8; ++idx) {
        const int dir = idx < 4 ? 1 : 0, step = idx & 3, jc = GC_JC(idx);
        const int rows = row0 + jc * 64;
        if (idx == 4) {
#pragma unroll
            for (int j = 0; j < 2; ++j) accS[j] = zst ? (f32x4){0.f, 0.f, 0.f, 0.f} : *(const f32x4*)(GST + base0 * 4096 + rr * 64 + (nb0 + j) * 16 + 4 * quad);
#pragma unroll
            for (int q = 0; q < 16; ++q) wa[q] = wa2[(size_t)q * 256 + h * 64 + gd];
            ba = gba[h * 64 + gd]; }
        LBAR();
        if (step == 0) {
#pragma unroll
            for (int j = 0; j < 2; ++j) *(LAS u32x2*)(ST + rr * LT + (nb0 + j) * 16 + 4 * quad) = pack4(accS[j]);
        }
        const bf16x8 qreg = pq, kreg = pk;
        *(LAS bf16x8*)(Vn + r * LT + c * 8) = pv_;
        if (tid < 256) *(LAS f32x4*)(glr_s + (tid >> 2) * 16 + (tid & 3) * 4) = pg;
        if (idx + 1 < 8) { const int nd = (idx + 1) < 4 ? 1 : 0; const int nrows = row0 + GC_JC(idx + 1) * 64; const bf16* rp = P + (size_t)(nrows + r) * NP + h * 64 + c * 8;
            pq = *(const bf16x8*)(rp + 1792); pk = *(const bf16x8*)(rp + 2048); pv_ = *(const bf16x8*)(rp + 2304);
            if (tid < 256) pg = *(const f32x4*)(SM + (size_t)(nrows + (tid >> 2)) * NSM + 16 + nd * 16 + (tid & 3) * 4); }
        u32x2 gate[2] = {{0u, 0u}, {0u, 0u}};
        if (dir == 0) {
#pragma unroll
            for (int j = 0; j < 2; ++j) gate[j] = *(const u32x2*)(P + (size_t)(rows + rr) * NP + 2560 + h * 64 + (nb0 + j) * 16 + 4 * quad);
        }
        LBAR();
        {
            float gv[8];
#pragma unroll
            for (int i = 0; i < 8; ++i) gv[i] = gla_glog(glr_s + (sg * 8 + i) * 16, wa, ba);
            if (dir == 0) {
#pragma unroll
                for (int i = 1; i < 8; ++i) gv[i] += gv[i - 1];
                segtot[sg * 64 + gd] = gv[7];
            } else {
#pragma unroll
                for (int i = 6; i >= 0; --i) gv[i] += gv[i + 1];
                segtot[sg * 64 + gd] = gv[0];
            }
            tr_tile(Vn, VT, nullptr, nullptr, wave, lane);
            LBAR();
            float off = 0.f, all = 0.f;
#pragma unroll
            for (int q = 0; q < 8; ++q) { const float tq = segtot[q * 64 + gd]; all += tq; if (dir == 0 ? (q < sg) : (q > sg)) off += tq; }
#pragma unroll
            for (int i = 0; i < 8; ++i) gl[(sg * 8 + i) * 64 + gd] = gv[i] + off;
            if (sg == 0) bend[gd] = all;
        }
        LBAR();
        {
            const f32x4 b0 = *(const LAS f32x4*)(gl + r * 64 + c * 8), b1 = *(const LAS f32x4*)(gl + r * 64 + c * 8 + 4);
            const f32x4 e0 = *(const LAS f32x4*)(bend + c * 8), e1 = *(const LAS f32x4*)(bend + c * 8 + 4);
            float qd[8], kd[8], kk[8];
#pragma unroll
            for (int i = 0; i < 8; ++i) { const float bc = i < 4 ? b0[i] : b1[i - 4]; const float be = i < 4 ? e0[i] : e1[i - 4]; const float qv = bfs2f(qreg[i]), kv = bfs2f(kreg[i]);
                qd[i] = qv * fexp(bc); kd[i] = kv * fexp(-bc); kk[i] = kv * fexp(be - bc); }
            u32x4 w;
            w.x = pk2(qd[0], qd[1]); w.y = pk2(qd[2], qd[3]); w.z = pk2(qd[4], qd[5]); w.w = pk2(qd[6], qd[7]); *(LAS u32x4*)(Qd + r * LT + c * 8) = w;
            w.x = pk2(kd[0], kd[1]); w.y = pk2(kd[2], kd[3]); w.z = pk2(kd[4], kd[5]); w.w = pk2(kd[6], kd[7]); *(LAS u32x4*)(Kd + r * LT + c * 8) = w;
            w.x = pk2(kk[0], kk[1]); w.y = pk2(kk[2], kk[3]); w.z = pk2(kk[4], kk[5]); w.w = pk2(kk[6], kk[7]); *(LAS u32x4*)(KKn + r * LT + c * 8) = w;
        }
        LBAR();
        tr_tile(KKn, KKT, nullptr, nullptr, wave, lane);
        { f32x4 at[2] = {{0.f, 0.f, 0.f, 0.f}, {0.f, 0.f, 0.f, 0.f}};
          mmS<2>(Qd, LT, Kd, LT, wave, lane, at);
#pragma unroll
          for (int j = 0; j < 2; ++j) { const int s0 = (nb0 + j) * 16 + 4 * quad; f32x4 a4;
#pragma unroll
              for (int i = 0; i < 4; ++i) { const int ss = s0 + i; const bool ok = dir == 0 ? (ss <= rr) : (ss >= rr); a4[i] = ok ? at[j][i] : 0.f; }
              *(LAS u32x2*)(Att + rr * LT + s0) = pack4(a4); } }
        LBAR();
        f32x4 hv[2] = {{0.f, 0.f, 0.f, 0.f}, {0.f, 0.f, 0.f, 0.f}};
        mmS<2>(Att, LT, VT, LT, wave, lane, hv);
        mmS<2>(Qd, LT, ST, LT, wave, lane, hv);
        LAS u32x2* sp = (LAS u32x2*)stash + ((jc * 8 + wave) * 2) * 64 + lane;
        if (dir == 1) { float one = 1.f; asm volatile("" : "+v"(one)); sp[0] = pack4(hv[0] * one); sp[64] = pack4(hv[1] * one); }
        else {
            float sq = 0.f;
#pragma unroll
            for (int j = 0; j < 2; ++j) { const u32x2 sv = sp[j * 64];
                hv[j][0] += __builtin_bit_cast(float, sv.x << 16); hv[j][1] += __builtin_bit_cast(float, sv.x & 0xffff0000u); hv[j][2] += __builtin_bit_cast(float, sv.y << 16); hv[j][3] += __builtin_bit_cast(float, sv.y & 0xffff0000u);
                sq += hv[j][0] * hv[j][0] + hv[j][1] * hv[j][1] + hv[j][2] * hv[j][2] + hv[j][3] * hv[j][3]; }
            sq += __shfl_xor(sq, 16); sq += __shfl_xor(sq, 32);
            if (quad == 0) ssq[(wave & 1) * 64 + rr] = sq;
            LBAR();
            const float rs = 1.f / sqrtf((ssq[rr] + ssq[64 + rr]) * (1.f / 64.f) + EPS);
#pragma unroll
            for (int j = 0; j < 2; ++j) { const f32x4 gnv = j == 0 ? gn0 : gn1; const u32x2 gt = gate[j];
                f32x4 o; o[0] = hv[j][0] * rs * gnv[0] * __builtin_bit_cast(float, gt.x << 16); o[1] = hv[j][1] * rs * gnv[1] * __builtin_bit_cast(float, gt.x & 0xffff0000u);
                o[2] = hv[j][2] * rs * gnv[2] * __builtin_bit_cast(float, gt.y << 16); o[3] = hv[j][3] * rs * gnv[3] * __builtin_bit_cast(float, gt.y & 0xffff0000u);
                *(u32x2*)(MIX + (size_t)(rows + rr) * DM + 768 + h * 64 + (nb0 + j) * 16 + 4 * quad) = pack4(o); }
        }
        if (step < 3) {
            f32x4 ut[2] = {{0.f, 0.f, 0.f, 0.f}, {0.f, 0.f, 0.f, 0.f}};
            mmS<2>(VT, LT, KKT, LT, wave, lane, ut);
#pragma unroll
            for (int j = 0; j < 2; ++j) { const f32x4 be = *(const LAS f32x4*)(bend + (nb0 + j) * 16 + 4 * quad);
#pragma unroll
                for (int i = 0; i < 4; ++i) accS[j][i] = accS[j][i] * fexp(be[i]) + ut[j][i]; }
            LBAR();
#pragma unroll
            for (int j = 0; j < 2; ++j) *(LAS u32x2*)(ST + rr * LT + (nb0 + j) * 16 + 4 * quad) = pack4(accS[j]);
        }
    }
#undef GC_JC
}

__device__ __forceinline__ int scan_grp(int dir, int step) { return step == 0 ? 16 : (dir == 0 ? step - 1 : 16 - step); }
__device__ __forceinline__ void mlstm_scan_task(const Ctx& F, int pair) {
    int tid_ = F.tid; asm volatile("" : "+v"(tid_)); const int tid = tid_;
    f32x4* MST4 = (f32x4*)(F.ws + WS_MST); const float* MSC = (const float*)(F.ws + WS_MSC); float* MPREV = (float*)(F.ws + WS_MSC) + 512 * NGRP * 2;
    f32x4 st[2][3]; float m[2] = {0.f, 0.f};
    float zz = 0.f; asm volatile("" : "+v"(zz));
#pragma unroll
    for (int d = 0; d < 2; ++d)
#pragma unroll
        for (int q = 0; q < 3; ++q) st[d][q] = (f32x4){zz, zz, zz, zz};
    const bool has3 = tid < 16;
    f32x4 cur[2][3];
#pragma unroll
    for (int d = 0; d < 2; ++d) { const size_t base = (size_t)(pair * 2 + d) * NGRP + scan_grp(d, 0);
        cur[d][0] = MST4[base * 1040 + tid]; cur[d][1] = MST4[base * 1040 + 512 + tid]; cur[d][2] = has3 ? MST4[base * 1040 + 1024 + tid] : (f32x4){zz, zz, zz, zz}; }
    for (int step = 0; step < NGRP; ++step) {
        f32x4 nxt[2][3];
        if (step + 1 < NGRP) {
#pragma unroll
            for (int d = 0; d < 2; ++d) { const size_t nb = (size_t)(pair * 2 + d) * NGRP + scan_grp(d, step + 1);
                nxt[d][0] = MST4[nb * 1040 + tid]; nxt[d][1] = MST4[nb * 1040 + 512 + tid]; nxt[d][2] = has3 ? MST4[nb * 1040 + 1024 + tid] : (f32x4){zz, zz, zz, zz}; }
        }
#pragma unroll
        for (int d = 0; d < 2; ++d) { const size_t base = (size_t)(pair * 2 + d) * NGRP + scan_grp(d, step);
            const float a = MSC[base * 2], mi = MSC[base * 2 + 1];
            const float mnew = fmaxf(a + m[d], mi), so = fexp(a + m[d] - mnew), sn = fexp(mi - mnew);
            MST4[base * 1040 + tid] = st[d][0]; MST4[base * 1040 + 512 + tid] = st[d][1]; if (has3) MST4[base * 1040 + 1024 + tid] = st[d][2];
            if (tid == 0) MPREV[base] = m[d];
#pragma unroll
            for (int q = 0; q < 3; ++q) st[d][q] = st[d][q] * so + cur[d][q] * sn;
            m[d] = mnew; }
        if (step + 1 < NGRP) {
#pragma unroll
            for (int d = 0; d < 2; ++d)
#pragma unroll
                for (int q = 0; q < 3; ++q) cur[d][q] = nxt[d][q];
        }
    }
}
__device__ __forceinline__ void gla_scan_task(const Ctx& F, int pair) {
    int tid_ = F.tid; asm volatile("" : "+v"(tid_)); const int tid = tid_;
    f32x4* GST4 = (f32x4*)(F.ws + WS_GST); const f32x4* GDEC4 = (const f32x4*)(F.ws + WS_GDEC);
    f32x4 st[2][2], cur[2][2], dcur[2];
    float zz = 0.f; asm volatile("" : "+v"(zz));
#pragma unroll
    for (int d = 0; d < 2; ++d) { st[d][0] = (f32x4){zz, zz, zz, zz}; st[d][1] = (f32x4){zz, zz, zz, zz};
        const size_t base = (size_t)(pair * 2 + d) * NGRP + scan_grp(d, 0);
        cur[d][0] = GST4[base * 1024 + tid]; cur[d][1] = GST4[base * 1024 + 512 + tid]; dcur[d] = GDEC4[base * 16 + (tid & 15)]; }
    for (int step = 0; step < NGRP; ++step) {
        f32x4 nxt[2][2], dnxt[2];
        if (step + 1 < NGRP) {
#pragma unroll
            for (int d = 0; d < 2; ++d) { const size_t nb = (size_t)(pair * 2 + d) * NGRP + scan_grp(d, step + 1);
                nxt[d][0] = GST4[nb * 1024 + tid]; nxt[d][1] = GST4[nb * 1024 + 512 + tid]; dnxt[d] = GDEC4[nb * 16 + (tid & 15)]; }
        }
#pragma unroll
        for (int d = 0; d < 2; ++d) { const size_t base = (size_t)(pair * 2 + d) * NGRP + scan_grp(d, step);
            GST4[base * 1024 + tid] = st[d][0]; GST4[base * 1024 + 512 + tid] = st[d][1];
            st[d][0] = st[d][0] * dcur[d] + cur[d][0]; st[d][1] = st[d][1] * dcur[d] + cur[d][1]; }
        if (step + 1 < NGRP) {
#pragma unroll
            for (int d = 0; d < 2; ++d) { cur[d][0] = nxt[d][0]; cur[d][1] = nxt[d][1]; dcur[d] = dnxt[d]; }
        }
    }
}

__device__ __forceinline__ void mixer_phase_a(const Ctx& F, int l, bool last) {
    const bf16* P = (const bf16*)(F.ws + WS_P); bf16* MIX = (bf16*)(F.ws + WS_H); const float* SM = (const float*)(F.ws + WS_SM);
    const int nattn = last ? NATT_LAT : NATT_LAT + NATT_CTX;
    const int vb = (F.G & 7) == 0 ? (F.bid & 7) * (F.G >> 3) + (F.bid >> 3) : F.bid;
    for (int t = vb; t < nattn + 2 * 1088; t += F.G) {
        if (t < nattn) { attn_task(F, t, P, MIX, F.in[9] + l * 8);
#ifdef DUP_ATT
            attn_task(F, t, P, MIX, F.in[9] + l * 8);
#endif
        }
        else if (t < nattn + 1088) { mlstm_a_task(F, t - nattn, P, SM);
#ifdef DUP_MLA
            mlstm_a_task(F, t - nattn, P, SM);
#endif
        }
        else { gla_a_task(F, t - nattn - 1088, P, SM, F.in[13] + (size_t)l * 2 * 16 * 256, F.in[14] + (size_t)l * 2 * 256);
#ifdef DUP_GLA
            gla_a_task(F, t - nattn - 1088, P, SM, F.in[13] + (size_t)l * 2 * 16 * 256, F.in[14] + (size_t)l * 2 * 256);
#endif
        }
    }
}
__device__ __forceinline__ void mixer_phase_b(const Ctx& F, int l, bool last) {
    for (int t = F.bid; t < 128; t += F.G) { if (t < 64) mlstm_scan_task(F, t); else gla_scan_task(F, t - 64); }
    if (F.G >= 256 && !last) {
        const bf16* P = (const bf16*)(F.ws + WS_P); bf16* MIX = (bf16*)(F.ws + WS_H); const float* SM = (const float*)(F.ws + WS_SM);
        for (int u = F.bid - 128; u >= 0 && u < 128; u += F.G - 128) {
            if (u < 64) mlstm_c_task(F, u * 17 + 16, P, SM, MIX, F.in[12] + l * 256);
            else gla_c_task(F, (u - 64) * 17 + 16, P, SM, MIX, F.in[13] + (size_t)l * 2 * 16 * 256, F.in[14] + (size_t)l * 2 * 256, F.in[15] + l * 256);
        }
    }
}
__device__ __forceinline__ void mixer_phase_c(const Ctx& F, int l, bool last) {
    const bf16* P = (const bf16*)(F.ws + WS_P); bf16* MIX = (bf16*)(F.ws + WS_H); const float* SM = (const float*)(F.ws + WS_SM);
    if (F.G >= 256) {
        for (int t = F.bid; t < 2048; t += F.G) { const int idx = t & 1023, tt = (idx >> 4) * 17 + (idx & 15);
            if (t < 1024) mlstm_c_task(F, tt, P, SM, MIX, F.in[12] + l * 256);
            else gla_c_task(F, tt, P, SM, MIX, F.in[13] + (size_t)l * 2 * 16 * 256, F.in[14] + (size_t)l * 2 * 256, F.in[15] + l * 256); }
        return;
    }
    for (int t = F.bid; t < 2 * 1088; t += F.G) {
        const int tt = t < 1088 ? t : t - 1088;
        if (last && (tt % 17) == 16) continue;
        if (t < 1088) mlstm_c_task(F, tt, P, SM, MIX, F.in[12] + l * 256);
        else gla_c_task(F, tt, P, SM, MIX, F.in[13] + (size_t)l * 2 * 16 * 256, F.in[14] + (size_t)l * 2 * 256, F.in[15] + l * 256);
    }
}
__global__ void __launch_bounds__(NT, 2) fwd_mega(Args args) {
    extern __shared__ __attribute__((aligned(16))) unsigned char lds_raw[];
    cg::grid_group grid = cg::this_grid();
    Ctx F;
    F.lds = (LAS unsigned char*)lds_raw;
#define REFRESH() do { int t_ = threadIdx.x; asm volatile("" : "+v"(t_)); F.tid = t_; F.lane = t_ & 63; F.wave = __builtin_amdgcn_readfirstlane(t_ >> 6); } while (0)
    REFRESH();
    volatile LAS unsigned* bst = (volatile LAS unsigned*)(F.lds + 139264);
    if (F.tid < 4) bst[F.tid] = 0u;
    __syncthreads();
    (void)xcd_barrier_post((unsigned*)(args.ws + WS_BAR), bst);
#define GSYNC() do { XcdBarrier xb_; xb_.bar = (unsigned*)(args.ws + WS_BAR); xb_.x = xb_xcc_id(); xb_.st = (volatile LAS unsigned*)(F.lds + 139264); xcd_barrier(xb_); REFRESH(); } while (0)
    F.G = gridDim.x; F.bid = blockIdx.x; F.in = args.in; F.out = args.out; F.ws = args.ws;
    unsigned char* ws = args.ws;
    bf16* Hb = (bf16*)(ws + WS_H); bf16* Pb = (bf16*)(ws + WS_P); bf16* HID = (bf16*)(ws + WS_HID);
    float* SM = (float*)(ws + WS_SM); float* XC = (float*)(ws + WS_XC); const float* MOD = (const float*)(ws + WS_MOD);

#ifndef NO_PRO
    prologue(F);
#endif
    grid.sync(); REFRESH();

    for (int l = 0; l < DEPTH; ++l) {
        const bool last = (l == DEPTH - 1);
        const float* srcL = l == 0 ? args.in[0] : args.out; const float* srcC = l == 0 ? args.in[2] : XC;
        const float* modl = MOD + (size_t)l * 17 * 6144;
        const int Mpost = last ? ML : MT;
#ifndef NO_N
        norm_phase(F, srcL, srcC, args.in[6] + l * DM, modl, MT, (l > 0 && F.G == 256) ? (const float*)(ws + WS_PART) : nullptr, XC);
#ifdef DUP_N
        GSYNC(); norm_phase(F, srcL, srcC, args.in[6] + l * DM, modl, MT, nullptr, XC);
#endif
#endif
        GSYNC();
#ifndef NO_G1
        { LAS float* rl = (LAS float*)(F.lds + 131072); *(LAS f32x4*)(rl + F.tid * 4) = F.tid < 256 ? *(const f32x4*)(ROPE_C + F.tid * 4) : *(const f32x4*)(ROPE_S + (F.tid - 256) * 4); __syncthreads(); }
        { pg8::Gemm g{Hb, (const bf16*)(ws + WS_WIN) + (size_t)l * NINP * DM, MT, NINP, DM}; pg8::StaticOrder S; S.init(MT, NINP, F.G, F.bid);
          EpiIn E{Pb, SM, args.in[10] + l * 8, args.in[11] + l * 8, (const LAS float*)(F.lds + 131072)};
          pg8::gemm_phase<EpiIn, pg8::StaticOrder, true, true>(F.lds, g, S, E);
#ifdef DUP_G1
          GSYNC(); pg8::gemm_phase<EpiIn, pg8::StaticOrder, true, true>(F.lds, g, S, E);
#endif
        }
#endif
        GSYNC();
#ifndef NO_MIX
        mixer_phase_a(F, l, last);
#ifdef DUP_MA
        GSYNC(); mixer_phase_a(F, l, last);
#endif
        GSYNC();
        mixer_phase_b(F, l, last);
        GSYNC();
        mixer_phase_c(F, l, last);
#ifdef DUP_MC
        GSYNC(); mixer_phase_c(F, l, last);
#endif
#endif
        GSYNC();
#ifndef NO_G2
        { pg8::Gemm g{Hb, (const bf16*)(ws + WS_WOUT) + (size_t)l * DM * DM, Mpost, DM, DM}; pg8::StaticOrder S; S.init(Mpost, DM, F.G, F.bid);
          EpiRes E{srcL, srcC, args.out, XC, modl + 2 * 1024, DM / 64, nullptr};
          pg8::gemm_phase<EpiRes, pg8::StaticOrder, true, true>(F.lds, g, S, E); }
#endif
        GSYNC();
#ifndef NO_N
        norm_phase(F, args.out, XC, args.in[7] + l * DM, modl + 3 * 1024, Mpost);
#ifdef DUP_N
        GSYNC(); norm_phase(F, args.out, XC, args.in[7] + l * DM, modl + 3 * 1024, Mpost);
#endif
#endif
        GSYNC();
#ifndef NO_G3
        { pg8::Gemm g{Hb, (const bf16*)(ws + WS_W1) + (size_t)l * FF * DM, Mpost, FF, DM}; pg8::StaticOrder S; S.init(Mpost, FF, F.G, F.bid);
          EpiRelu2 E{HID};
          pg8::gemm_phase<EpiRelu2, pg8::StaticOrder, true, true>(F.lds, g, S, E);
#ifdef DUP_G3
          GSYNC(); pg8::gemm_phase<EpiRelu2, pg8::StaticOrder, true, true>(F.lds, g, S, E);
#endif
        }
#endif
        GSYNC();
#ifndef NO_G4
        { pg8::Gemm g{HID, (const bf16*)(ws + WS_W2) + (size_t)l * DM * FF, Mpost, DM, FF};
          EpiRes E{args.out, XC, args.out, XC, modl + 5 * 1024, FF / 64, (float*)(ws + WS_PART)};
          if (last || F.G != 256) { pg8::StaticOrder S; S.init(Mpost, DM, F.G, F.bid, FF); pg8::gemm_phase<EpiRes, pg8::StaticOrder, true, true>(F.lds, g, S, E); }
          else { SplitOrder S; S.init(ML, DM, F.G, F.bid, FF); pg8::gemm_phase<EpiRes, SplitOrder, true, true>(F.lds, g, S, E); } }
#endif
        GSYNC();
    }
    final_norm(F);
}

extern "C" void kernel_launch(void* const* d_in, const int* in_sizes, int n_in, void* d_out, int out_size, void* d_ws, size_t ws_size, hipStream_t stream) {
    static int grid = 0;
    if (grid == 0) {
        if (n_in != 20 || out_size != ML * DM || ws_size < WS_END) { fprintf(stderr, "kernel_launch: unexpected shapes n_in %d out %d ws %zu\n", n_in, out_size, ws_size); grid = -1; return; }
        int dev = 0, cus = 0, per_cu = 0;
        (void)hipGetDevice(&dev); (void)hipDeviceGetAttribute(&cus, hipDeviceAttributeMultiprocessorCount, dev);
        if (hipFuncSetAttribute((const void*)fwd_mega, hipFuncAttributeMaxDynamicSharedMemorySize, LDS_BYTES) != hipSuccess) { fprintf(stderr, "kernel_launch: hipFuncSetAttribute failed\n"); grid = -1; return; }
        if (hipOccupancyMaxActiveBlocksPerMultiprocessor(&per_cu, (const void*)fwd_mega, NT, LDS_BYTES) != hipSuccess || per_cu < 1) { fprintf(stderr, "kernel_launch: occupancy query says %d\n", per_cu); per_cu = 1; }
        (void)hipGetLastError();
        grid = cus * 1;
        if (grid <= 0) grid = 256;
    }
    if (grid < 0) return;
    Args a{};
    for (int i = 0; i < 20; ++i) a.in[i] = (const float*)d_in[i];
    a.out = (float*)d_out; a.ws = (unsigned char*)d_ws;
    if (hipMemsetAsync((char*)d_ws + WS_BAR, 0, 16384, stream) != hipSuccess) { fprintf(stderr, "kernel_launch: memset of the barrier words failed\n"); return; }
    void* kargs[] = {&a};
    const hipError_t e = hipLaunchCooperativeKernel((const void*)fwd_mega, dim3(grid), dim3(NT), kargs, LDS_BYTES, stream);
    if (e != hipSuccess) fprintf(stderr, "kernel_launch: cooperative launch failed: %s (grid %d)\n", hipGetErrorString(e), grid);
}
```

```cpp
#include <hip/hip_runtime.h>
#include <hip/hip_cooperative_groups.h>
#include <cstdio>
#include <cstdint>
namespace cg = cooperative_groups;
__device__ const float ROPE_C[1024] = {1.000000000e+00f,1.000000000e+00f,1.000000000e+00f,1.000000000e+00f,1.000000000e+00f,1.000000000e+00f,1.000000000e+00f,1.000000000e+00f,1.000000000e+00f,1.000000000e+00f,1.000000000e+00f,1.000000000e+00f,1.000000000e+00f,1.000000000e+00f,1.000000000e+00f,1.000000000e+00f,5.403022766e-01f,8.460091352e-01f,9.504152536e-01f,9.842302203e-01f,9.950041771e-01f,9.984192848e-01f,9.995000362e-01f,9.998418689e-01f,9.999499917e-01f,9.999842048e-01f,9.999949932e-01f,9.999983907e-01f,9.999995232e-01f,9.999998212e-01f,9.999999404e-01f,1.000000000e+00f,-4.161468446e-01f,4.314628243e-01f,8.065783978e-01f,9.374182820e-01f,9.800665975e-01f,9.936820865e-01f,9.980006814e-01f,9.993675947e-01f,9.998000264e-01f,9.999367595e-01f,9.999799728e-01f,9.999936819e-01f,9.999979734e-01f,9.999993443e-01f,9.999998212e-01f,9.999999404e-01f,-9.899924994e-01f,-1.159661636e-01f,5.827535987e-01f,8.610406518e-01f,9.553365111e-01f,9.858034849e-01f,9.955033660e-01f,9.985772967e-01f,9.995500445e-01f,9.998577237e-01f,9.999549985e-01f,9.999857545e-01f,9.999955297e-01f,9.999985695e-01f,9.999995232e-01f,9.999998808e-01f,-6.536436081e-01f,-6.276797056e-01f,3.011374772e-01f,7.575061917e-01f,9.210609794e-01f,9.748082757e-01f,9.920106530e-01f,9.974712729e-01f,9.992001057e-01f,9.997470379e-01f,9.999200106e-01f,9.999747276e-01f,9.999920130e-01f,9.999974966e-01f,9.999992251e-01f,9.999997616e-01f,2.836622000e-01f,-9.460792542e-01f,-1.034230832e-02f,6.300802827e-01f,8.775825500e-01f,9.607312679e-01f,9.875259995e-01f,9.960497618e-01f,9.987502694e-01f,9.996047616e-01f,9.998750091e-01f,9.999604821e-01f,9.999874830e-01f,9.999960661e-01f,9.999987483e-01f,9.999995828e-01f,9.601702690e-01f,-9.731037021e-01f,-3.207964599e-01f,4.827820063e-01f,8.253356218e-01f,9.436169863e-01f,9.820539355e-01f,9.943132997e-01f,9.982005358e-01f,9.994308352e-01f,9.998199940e-01f,9.999430776e-01f,9.999819994e-01f,9.999943376e-01f,9.999982119e-01f,9.999994040e-01f,7.539022565e-01f,-7.004299164e-01f,-5.994373560e-01f,3.202569783e-01f,7.648421526e-01f,9.235194325e-01f,9.755998850e-01f,9.922624230e-01f,9.975510240e-01f,9.992253184e-01f,9.997550249e-01f,9.999225140e-01f,9.999755025e-01f,9.999922514e-01f,9.999975562e-01f,9.999992251e-01f,-1.455000341e-01f,-2.120364457e-01f,-8.186324239e-01f,1.476312131e-01f,6.967067122e-01f,9.005023241e-01f,9.681702852e-01f,9.898977876e-01f,9.968017340e-01f,9.989882708e-01f,9.996800423e-01f,9.998987913e-01f,9.999679923e-01f,9.999898672e-01f,9.999967813e-01f,9.999989867e-01f,-9.111302495e-01f,3.416603804e-01f,-9.566441774e-01f,-2.965078130e-02f,6.216099858e-01f,8.746382594e-01f,9.597726464e-01f,9.872201085e-01f,9.959527254e-01f,9.987195730e-01f,9.995950460e-01f,9.998719096e-01f,9.999595284e-01f,9.999871850e-01f,9.999959469e-01f,9.999987483e-01f,-8.390715122e-01f,7.901319861e-01f,-9.997860789e-01f,-2.059976012e-01f,5.403022766e-01f,8.460091352e-01f,9.504153132e-01f,9.842302203e-01f,9.950041771e-01f,9.984192848e-01f,9.995000362e-01f,9.998418689e-01f,9.999499917e-01f,9.999842048e-01f,9.999949932e-01f,9.999983907e-01f,4.425697960e-03f,9.952573776e-01f,-9.437797070e-01f,-3.758473694e-01f,4.535961151e-01f,8.147053123e-01f,9.401075840e-01f,9.809291363e-01f,9.939560890e-01f,9.980874062e-01f,9.993950725e-01f,9.998086691e-01f,9.999395013e-01f,9.999808669e-01f,9.999939203e-01f,9.999980927e-01f,8.438539505e-01f,8.938615918e-01f,-7.941792607e-01f,-5.338430405e-01f,3.623577356e-01f,7.808259130e-01f,9.288598895e-01f,9.773178697e-01f,9.928086400e-01f,9.977239966e-01f,9.992800951e-01f,9.997723103e-01f,9.999279976e-01f,9.999772310e-01f,9.999927878e-01f,9.999977350e-01f,9.074468017e-01f,5.171727538e-01f,-5.658205152e-01f,-6.750016212e-01f,2.674988210e-01f,7.444779873e-01f,9.166833758e-01f,9.733975530e-01f,9.915618896e-01f,9.973290563e-01f,9.991551042e-01f,9.997327924e-01f,9.999154806e-01f,9.999732971e-01f,9.999915361e-01f,9.999973178e-01f,1.367372125e-01f,-1.879591309e-02f,-2.813496590e-01f,-7.948709130e-01f,1.699671149e-01f,7.057763934e-01f,9.035902619e-01f,9.691694379e-01f,9.902160168e-01f,9.969025850e-01f,9.990201592e-01f,9.996901155e-01f,9.999020100e-01f,9.999690056e-01f,9.999902248e-01f,9.999969006e-01f,-7.596879005e-01f,-5.489757657e-01f,3.102250025e-02f,-8.896703720e-01f,7.073718309e-02f,6.648435593e-01f,8.895936012e-01f,9.646348357e-01f,9.887710810e-01f,9.964445233e-01f,9.988752007e-01f,9.996442795e-01f,9.998875260e-01f,9.999644160e-01f,9.999887347e-01f,9.999964237e-01f,-9.576594830e-01f,-9.100810885e-01f,3.403181732e-01f,-9.564100504e-01f,-2.919954620e-02f,6.218088269e-01f,8.747074604e-01f,9.597951770e-01f,9.872272611e-01f,9.959549904e-01f,9.987202883e-01f,9.995952845e-01f,9.998720288e-01f,9.999595284e-01f,9.999871850e-01f,9.999959469e-01f,-2.751633525e-01f,-9.908980131e-01f,6.158646941e-01f,-9.929850101e-01f,-1.288445145e-01f,5.768082738e-01f,8.589466810e-01f,9.546520114e-01f,9.855847955e-01f,9.954339862e-01f,9.985553622e-01f,9.995430708e-01f,9.998555183e-01f,9.999542832e-01f,9.999855757e-01f,9.999954104e-01f,6.603167057e-01f,-7.665364146e-01f,8.303362131e-01f,-9.982416630e-01f,-2.272021174e-01f,5.299842358e-01f,8.423270583e-01f,9.492070079e-01f,9.838436842e-01f,9.948815107e-01f,9.983804226e-01f,9.994877577e-01f,9.998379946e-01f,9.999487996e-01f,9.999837875e-01f,9.999948740e-01f,9.887046218e-01f,-3.060955107e-01f,9.624637961e-01f,-9.720142484e-01f,-3.232896030e-01f,4.814846218e-01f,8.248651624e-01f,9.434618354e-01f,9.820042253e-01f,9.942975044e-01f,9.981955290e-01f,9.994292855e-01f,9.998195171e-01f,9.999428988e-01f,9.999819398e-01f,9.999942780e-01f,4.080820680e-01f,2.486171871e-01f,9.991443753e-01f,-9.151299596e-01f,-4.161468744e-01f,4.314628243e-01f,8.065784574e-01f,9.374182820e-01f,9.800665975e-01f,9.936820865e-01f,9.980006814e-01f,9.993675947e-01f,9.998000264e-01f,9.999367595e-01f,9.999799728e-01f,9.999936819e-01f,-5.477292538e-01f,7.267603278e-01f,9.367403984e-01f,-8.293828964e-01f,-5.048461556e-01f,3.800770044e-01f,7.874851823e-01f,9.310783744e-01f,9.780309200e-01f,9.930352569e-01f,9.977958202e-01f,9.993028045e-01f,9.997795224e-01f,9.999302626e-01f,9.999779463e-01f,9.999930263e-01f,-9.999608397e-01f,9.810745120e-01f,7.814403772e-01f,-7.174775004e-01f,-5.885011554e-01f,3.274895847e-01f,7.676045895e-01f,9.244439602e-01f,9.758974314e-01f,9.923570156e-01f,9.975810051e-01f,9.992348552e-01f,9.997580051e-01f,9.999234676e-01f,9.999758005e-01f,9.999923706e-01f,-5.328330398e-01f,9.332356453e-01f,5.486453176e-01f,-5.829432011e-01f,-6.662760377e-01f,2.738668323e-01f,7.469564080e-01f,9.175173044e-01f,9.736663699e-01f,9.916474223e-01f,9.973561764e-01f,9.991636872e-01f,9.997355342e-01f,9.999163747e-01f,9.999735355e-01f,9.999916553e-01f,4.241790175e-01f,5.979771614e-01f,2.614414692e-01f,-4.300231636e-01f,-7.373937368e-01f,2.193782479e-01f,7.255613208e-01f,9.103004336e-01f,9.713379741e-01f,9.909064770e-01f,9.971213937e-01f,9.990894198e-01f,9.997119904e-01f,9.999089241e-01f,9.999712110e-01f,9.999908805e-01f,9.912028313e-01f,7.855261862e-02f,-5.168941990e-02f,-2.635403872e-01f,-8.011436462e-01f,1.641961187e-01f,7.034407258e-01f,9.027957320e-01f,9.689124227e-01f,9.901341200e-01f,9.968766570e-01f,9.990119338e-01f,9.996874928e-01f,9.999011755e-01f,9.999687672e-01f,9.999901056e-01f,6.469193101e-01f,-4.650647044e-01f,-3.596942723e-01f,-8.874565363e-02f,-8.568887711e-01f,1.084948927e-01f,6.806167960e-01f,8.950055838e-01f,9.663899541e-01f,9.893305302e-01f,9.966219068e-01f,9.989313483e-01f,9.996620417e-01f,9.998931289e-01f,9.999662042e-01f,9.999893308e-01f,-2.921388149e-01f,-8.654505610e-01f,-6.320284605e-01f,8.884806931e-02f,-9.040721655e-01f,5.245067179e-02f,6.571123004e-01f,8.869323730e-01f,9.637709260e-01f,9.884956479e-01f,9.963572025e-01f,9.988475442e-01f,9.996355176e-01f,9.998847246e-01f,9.999635220e-01f,9.999884963e-01f,-9.626058936e-01f,-9.992934465e-01f,-8.416847587e-01f,2.636395693e-01f,-9.422223568e-01f,-3.759374376e-03f,6.329507232e-01f,8.785787225e-01f,9.610554576e-01f,9.876294732e-01f,9.960825443e-01f,9.987606406e-01f,9.996080399e-01f,9.998760223e-01f,9.999607801e-01f,9.999876022e-01f,-7.480575442e-01f,-8.253720999e-01f,-9.678716063e-01f,4.301159978e-01f,-9.709581733e-01f,-5.995753407e-02f,6.081562042e-01f,8.699471951e-01f,9.582439065e-01f,9.867320657e-01f,9.957979321e-01f,9.986705780e-01f,9.995795488e-01f,9.998670220e-01f,9.999579787e-01f,9.999867082e-01f,1.542514563e-01f,-3.972512186e-01f,-9.980751872e-01f,5.830267668e-01f,-9.899924994e-01f,-1.159661412e-01f,5.827536583e-01f,8.610406518e-01f,9.553365111e-01f,9.858034849e-01f,9.955033660e-01f,9.985772967e-01f,9.995500445e-01f,9.998577237e-01f,9.999549985e-01f,9.999857545e-01f,9.147423506e-01f,1.532158256e-01f,-9.293002486e-01f,7.175491452e-01f,-9.991351366e-01f,-1.716081202e-01f,5.567683578e-01f,8.518617749e-01f,9.523335695e-01f,9.848436713e-01f,9.951988459e-01f,9.984809160e-01f,9.995195270e-01f,9.998480678e-01f,9.999519587e-01f,9.999848008e-01f,8.342233896e-01f,6.564951539e-01f,-7.683671117e-01f,8.294403553e-01f,-9.982947707e-01f,-2.267075777e-01f,5.302263498e-01f,8.424135447e-01f,9.492354393e-01f,9.838528037e-01f,9.948843718e-01f,9.983813763e-01f,9.994880557e-01f,9.998381138e-01f,9.999487996e-01f,9.999837875e-01f,-1.327674743e-02f,9.575859904e-01f,-5.312353969e-01f,9.151714444e-01f,-9.874797463e-01f,-2.810903192e-01f,5.031541586e-01f,8.326989412e-01f,9.460423589e-01f,9.828307629e-01f,9.945599437e-01f,9.982786179e-01f,9.994555712e-01f,9.998278022e-01f,9.999455214e-01f,9.999827743e-01f,-8.485702872e-01f,9.637577534e-01f,-2.414214015e-01f,9.720383883e-01f,-9.667981863e-01f,-3.345844150e-01f,4.755788743e-01f,8.227210045e-01f,9.427546859e-01f,9.817776680e-01f,9.942255616e-01f,9.981727600e-01f,9.994220734e-01f,9.998172522e-01f,9.999421835e-01f,9.999817014e-01f,-9.036921859e-01f,6.731096506e-01f,7.233422250e-02f,9.982477427e-01f,-9.364566803e-01f,-3.870207071e-01f,4.475280344e-01f,8.124828935e-01f,9.393727183e-01f,9.806935191e-01f,9.938812256e-01f,9.980637431e-01f,9.993875623e-01f,9.998063445e-01f,9.999387264e-01f,9.999806285e-01f,-1.279636919e-01f,1.751560569e-01f,3.789165020e-01f,9.929728508e-01f,-8.967583776e-01f,-4.382334948e-01f,4.190297127e-01f,8.019878864e-01f,9.358968139e-01f,9.795783162e-01f,9.935269952e-01f,9.979515672e-01f,9.993520975e-01f,9.997950792e-01f,9.999352098e-01f,9.999794960e-01f,7.654140592e-01f,-3.767423928e-01f,6.479218602e-01f,9.563800097e-01f,-8.481000066e-01f,-4.880608022e-01f,3.901124001e-01f,7.912392616e-01f,9.323273301e-01f,9.784321785e-01f,9.931628108e-01f,9.978361726e-01f,9.993155599e-01f,9.997835755e-01f,9.999315739e-01f,9.999783635e-01f,9.550736547e-01f,-8.126110435e-01f,8.526731730e-01f,8.896234035e-01f,-7.909677029e-01f,-5.363451242e-01f,3.608050048e-01f,7.802404165e-01f,9.286646247e-01f,9.772551060e-01f,9.927886724e-01f,9.977176785e-01f,9.992780685e-01f,9.997717142e-01f,9.999278188e-01f,9.999771714e-01f,2.666429281e-01f,-9.982103109e-01f,9.728653431e-01f,7.948085070e-01f,-7.259322405e-01f,-5.829338431e-01f,3.311368227e-01f,7.689948678e-01f,9.249090552e-01f,9.760470986e-01f,9.924046397e-01f,9.975960255e-01f,9.992396235e-01f,9.997594953e-01f,9.999239445e-01f,9.999759793e-01f,-6.669380665e-01f,-8.763789535e-01f,9.965789914e-01f,6.749257445e-01f,-6.536435485e-01f,-6.276796460e-01f,3.011375368e-01f,7.575061917e-01f,9.210609794e-01f,9.748082757e-01f,9.920106530e-01f,9.974712729e-01f,9.992001057e-01f,9.997470379e-01f,9.999200106e-01f,9.999747276e-01f,-9.873392582e-01f,-4.846388698e-01f,9.214624763e-01f,5.337561369e-01f,-5.748239160e-01f,-6.704410911e-01f,2.708371282e-01f,7.457779050e-01f,9.171208143e-01f,9.735385776e-01f,9.916067719e-01f,9.973433018e-01f,9.991596341e-01f,9.997342229e-01f,9.999159575e-01f,9.999734163e-01f,-3.999853134e-01f,5.636117980e-02f,7.549650669e-01f,3.757520616e-01f,-4.902607799e-01f,-7.110829353e-01f,2.402659208e-01f,7.338138223e-01f,9.130889177e-01f,9.722381234e-01f,9.911929369e-01f,9.972121716e-01f,9.991181493e-01f,9.997211099e-01f,9.999117851e-01f,9.999721050e-01f,5.551133156e-01f,5.800030231e-01f,5.135982037e-01f,2.058969885e-01f,-4.007991254e-01f,-7.494767904e-01f,2.094544619e-01f,7.216176987e-01f,9.089657664e-01f,9.709069133e-01f,9.907692075e-01f,9.970778823e-01f,9.990756512e-01f,9.997076392e-01f,9.999075532e-01f,9.999707937e-01f,9.998432994e-01f,9.250144958e-01f,2.212980539e-01f,2.954799868e-02f,-3.073328137e-01f,-7.855011225e-01f,1.784335524e-01f,7.091933489e-01f,9.047516584e-01f,9.695450068e-01f,9.903355837e-01f,9.969404936e-01f,9.990321398e-01f,9.996939301e-01f,9.999032021e-01f,9.999693632e-01f,5.253219604e-01f,9.851383567e-01f,-9.294807911e-02f,-1.477329135e-01f,-2.107957304e-01f,-8.190422058e-01f,1.472342461e-01f,6.965447664e-01f,9.004471302e-01f,9.681524634e-01f,9.898920655e-01f,9.967998862e-01f,9.989876747e-01f,9.996798635e-01f,9.998987317e-01f,9.999679923e-01f,-4.321779311e-01f,7.418575287e-01f,-3.979766071e-01f,-3.203544021e-01f,-1.121524572e-01f,-8.499939442e-01f,1.158877090e-01f,6.836758852e-01f,8.960524797e-01f,9.667292237e-01f,9.894386530e-01f,9.966561794e-01f,9.989421964e-01f,9.996654391e-01f,9.998942018e-01f,9.999665618e-01f,-9.923354983e-01f,2.700981200e-01f,-6.635380387e-01f,-4.828720689e-01f,-1.238859352e-02f,-8.782584071e-01f,8.442529291e-02f,6.705908775e-01f,8.915683031e-01f,9.652754664e-01f,9.889753461e-01f,9.965093136e-01f,9.988957047e-01f,9.996507764e-01f,9.998895526e-01f,9.999650717e-01f,-6.401443481e-01f,-2.848466039e-01f,-8.632967472e-01f,-6.301601529e-01f,8.749905229e-02f,-9.037463665e-01f,5.287845805e-02f,6.572937369e-01f,8.869948983e-01f,9.637911916e-01f,9.885020852e-01f,9.963592887e-01f,9.988481998e-01f,9.996357560e-01f,9.998847842e-01f,9.999635816e-01f,3.005925417e-01f,-7.520637512e-01f,-9.774428010e-01f,-7.575733066e-01f,1.865124404e-01f,-9.263771772e-01f,2.127875015e-02f,6.437888145e-01f,8.823328614e-01f,9.622764587e-01f,9.880189896e-01f,9.962061048e-01f,9.987997413e-01f,9.996203780e-01f,9.998799562e-01f,9.999620318e-01f,9.649659991e-01f,-9.876589775e-01f,-9.946563840e-01f,-8.610929251e-01f,2.836622596e-01f,-9.460792542e-01f,-1.034223381e-02f,6.300802827e-01f,8.775825500e-01f,9.607312679e-01f,9.875259995e-01f,9.960497618e-01f,9.987502694e-01f,9.996047616e-01f,9.998750091e-01f,9.999604821e-01f,7.421541810e-01f,-9.190732241e-01f,-9.132304788e-01f,-9.374541044e-01f,3.779778183e-01f,-9.627903700e-01f,-4.195287824e-02f,6.161725521e-01f,8.727445006e-01f,9.591556787e-01f,9.870231748e-01f,9.958902597e-01f,9.986997843e-01f,9.995887876e-01f,9.998699427e-01f,9.999588728e-01f,-1.629907787e-01f,-5.674296618e-01f,-7.412400246e-01f,-9.842483997e-01f,4.685167372e-01f,-9.764577150e-01f,-7.352156937e-02f,6.020699143e-01f,8.678191900e-01f,9.575498104e-01f,9.865104556e-01f,9.957276583e-01f,9.986482859e-01f,9.995725155e-01f,9.998648167e-01f,9.999572635e-01f,-9.182828069e-01f,-4.102807119e-02f,-4.957412183e-01f,-1.000000000e+00f,5.543743968e-01f,-9.870380163e-01f,-1.050167456e-01f,5.877768993e-01f,8.628070951e-01f,9.559136033e-01f,9.859878421e-01f,9.955618382e-01f,9.985958338e-01f,9.995558858e-01f,9.998595715e-01f,9.999555945e-01f,-8.293098211e-01f,4.980093837e-01f,-2.010800242e-01f,-9.842120409e-01f,6.346929669e-01f,-9.944978356e-01f,-1.364069134e-01f,5.732980371e-01f,8.577086926e-01f,9.542471766e-01f,9.854553938e-01f,9.953929186e-01f,9.985423684e-01f,9.995389581e-01f,9.998542070e-01f,9.999538660e-01f,2.212675661e-02f,8.836690187e-01f,1.135221645e-01f,-9.373825192e-01f,7.086698413e-01f,-9.988136292e-01f,-1.676606983e-01f,5.586379170e-01f,8.525245190e-01f,9.525505900e-01f,9.849131107e-01f,9.952208400e-01f,9.984878898e-01f,9.995217323e-01f,9.998487830e-01f,9.999521971e-01f,8.532201052e-01f,9.971746802e-01f,4.168664217e-01f,-8.609883785e-01f,7.755659223e-01f,-9.999717474e-01f,-1.987468153e-01f,5.438010693e-01f,8.472551107e-01f,9.508239031e-01f,9.843609333e-01f,9.950456619e-01f,9.984323978e-01f,9.995042086e-01f,9.998431802e-01f,9.999504089e-01f,8.998668194e-01f,8.035687208e-01f,6.788702607e-01f,-7.574390173e-01f,8.347128034e-01f,-9.979684949e-01f,-2.296342254e-01f,5.287923217e-01f,8.419010043e-01f,9.490671158e-01f,9.837989211e-01f,9.948672652e-01f,9.983759522e-01f,9.994863272e-01f,9.998375773e-01f,9.999486208e-01f,1.191801354e-01f,3.624782264e-01f,8.735509515e-01f,-6.300004721e-01f,8.855195642e-01f,-9.928101897e-01f,-2.602919936e-01f,5.136163235e-01f,8.364626765e-01f,9.472803473e-01f,9.832270741e-01f,9.946857691e-01f,9.983184934e-01f,9.994681478e-01f,9.998317957e-01f,9.999468327e-01f,-7.710801959e-01f,-1.902489811e-01f,9.816020727e-01f,-4.826919436e-01f,9.274784923e-01f,-9.845131636e-01f,-2.906895280e-01f,4.982779622e-01f,8.309406638e-01f,9.454635978e-01f,9.826454520e-01f,9.945011139e-01f,9.982600212e-01f,9.994496703e-01f,9.998259544e-01f,9.999449849e-01f,-9.524129629e-01f,-6.843829751e-01f,9.923082590e-01f,-3.201595843e-01f,9.601703286e-01f,-9.731037021e-01f,-3.207963705e-01f,4.827819765e-01f,8.253356218e-01f,9.436169863e-01f,9.820539355e-01f,9.943132997e-01f,9.982005358e-01f,9.994308352e-01f,9.998199940e-01f,9.999430776e-01f,-2.581016421e-01f,-9.677394629e-01f,9.046077728e-01f,-1.475295126e-01f,9.832684398e-01f,-9.586178064e-01f,-3.505824506e-01f,4.671333730e-01f,8.196480274e-01f,9.417404532e-01f,9.814526439e-01f,9.941223264e-01f,9.981400967e-01f,9.994117022e-01f,9.998139739e-01f,9.999411702e-01f,6.735071540e-01f,-9.530498385e-01f,7.271978855e-01f,2.975356206e-02f,9.965420961e-01f,-9.411013126e-01f,-3.800179660e-01f,4.513370097e-01f,8.138784766e-01f,9.398342371e-01f,9.808415174e-01f,9.939282537e-01f,9.980786443e-01f,9.993922710e-01f,9.998078346e-01f,9.999392033e-01f,9.858965874e-01f,-6.448382139e-01f,4.776721597e-01f,2.060982287e-01f,9.998586178e-01f,-9.206095338e-01f,-4.090735018e-01f,4.353979528e-01f,8.080275059e-01f,9.378982186e-01f,9.802205563e-01f,9.937310219e-01f,9.980161786e-01f,9.993724823e-01f,9.998015761e-01f,9.999372363e-01f};
__device__ const float ROPE_S[1024] = {0.000000000e+00f,0.000000000e+00f,0.000000000e+00f,0.000000000e+00f,0.000000000e+00f,0.000000000e+00f,0.000000000e+00f,0.000000000e+00f,0.000000000e+00f,0.000000000e+00f,0.000000000e+00f,0.000000000e+00f,0.000000000e+00f,0.000000000e+00f,0.000000000e+00f,0.000000000e+00f,8.414709568e-01f,5.331684351e-01f,3.109835982e-01f,1.768921912e-01f,9.983342141e-02f,5.620449781e-02f,3.161750361e-02f,1.778185740e-02f,9.999833070e-03f,5.623383448e-03f,3.162272274e-03f,1.778278500e-03f,9.999999311e-04f,5.623412435e-04f,3.162277571e-04f,1.778279402e-04f,9.092974067e-01f,9.021307230e-01f,5.911270976e-01f,3.482052684e-01f,1.986693293e-01f,1.122313142e-01f,6.320339441e-02f,3.555808961e-02f,1.999866590e-02f,1.124658901e-02f,6.324512884e-03f,3.556551412e-03f,1.999998698e-03f,1.124682371e-03f,6.324554561e-04f,3.556558804e-04f,1.411200017e-01f,9.932531714e-01f,8.126488924e-01f,5.085361600e-01f,2.955202162e-01f,1.679033041e-01f,9.472608566e-02f,5.332308263e-02f,2.999549918e-02f,1.686943881e-02f,9.486690164e-03f,5.334813148e-03f,2.999995602e-03f,1.687023090e-03f,9.486831259e-04f,5.334838061e-04f,-7.568024993e-01f,7.784717083e-01f,9.535807371e-01f,6.528279781e-01f,3.894183338e-01f,2.230444849e-01f,1.261540651e-01f,7.107120752e-02f,3.998933360e-02f,2.249175683e-02f,1.264877338e-02f,7.113057654e-03f,3.999989480e-03f,2.249363344e-03f,1.264910679e-03f,7.113117026e-04f,-9.589242935e-01f,3.239351809e-01f,9.999465346e-01f,7.765299678e-01f,4.794255495e-01f,2.774805427e-01f,1.574558914e-01f,8.879686147e-02f,4.997916892e-02f,2.811336145e-02f,1.581072994e-02f,8.891279809e-03f,4.999979399e-03f,2.811702900e-03f,1.581138116e-03f,8.891395992e-04f,-2.794154882e-01f,-2.303675115e-01f,9.471481442e-01f,8.757405877e-01f,5.646424890e-01f,3.310393393e-01f,1.886002719e-01f,1.064944416e-01f,5.996400490e-02f,3.373407945e-02f,1.897252724e-02f,1.066947449e-02f,5.999964196e-03f,3.374041524e-03f,1.897365437e-03f,1.066967496e-03f,6.569865942e-01f,-7.137212157e-01f,8.004216552e-01f,9.473307133e-01f,6.442176700e-01f,3.835515678e-01f,2.195560783e-01f,1.241583377e-01f,6.994284689e-02f,3.935372829e-02f,2.213413641e-02f,1.244763471e-02f,6.999942940e-03f,3.936378751e-03f,2.213592408e-03f,1.244795276e-03f,9.893582463e-01f,-9.772617817e-01f,5.743177533e-01f,9.890424609e-01f,7.173560858e-01f,4.348512292e-01f,2.502923310e-01f,1.417829692e-01f,7.991468906e-02f,4.497213289e-02f,2.529552206e-02f,1.422575582e-02f,7.999914698e-03f,4.498715047e-03f,2.529819263e-03f,1.422623056e-03f,4.121184945e-01f,-9.398235083e-01f,2.912591398e-01f,9.995602965e-01f,7.833269238e-01f,4.847761393e-01f,2.807783484e-01f,1.593627781e-01f,8.987854421e-02f,5.058911443e-02f,2.845665626e-02f,1.600383222e-02f,8.999878541e-03f,5.061049946e-03f,2.846045885e-03f,1.600450836e-03f,-5.440211296e-01f,-6.129366755e-01f,-2.068351023e-02f,9.785525203e-01f,8.414710164e-01f,5.331684351e-01f,3.109835684e-01f,1.768921912e-01f,9.983341396e-02f,5.620449781e-02f,3.161750734e-02f,1.778185740e-02f,9.999834001e-03f,5.623383448e-03f,3.162272274e-03f,1.778278500e-03f,-9.999902248e-01f,-9.727657586e-02f,-3.305749893e-01f,9.266815782e-01f,8.912073970e-01f,5.798751712e-01f,3.408778608e-01f,1.943656653e-01f,1.097782999e-01f,6.181810424e-02f,3.477803990e-02f,1.955982670e-02f,1.099977829e-02f,6.185715087e-03f,3.478498198e-03f,1.956106164e-03f,-5.365729332e-01f,4.483429790e-01f,-6.076835394e-01f,8.455835581e-01f,9.320390821e-01f,6.247486472e-01f,3.704313040e-01f,2.117776722e-01f,1.197122037e-01f,6.742975861e-02f,3.793822601e-02f,2.133773454e-02f,1.199971233e-02f,6.748044398e-03f,3.794723889e-03f,2.133933594e-03f,4.201670289e-01f,8.558810353e-01f,-8.245284557e-01f,7.378162742e-01f,9.635581970e-01f,6.676470041e-01f,3.996143341e-01f,2.291227132e-01f,1.296341419e-01f,7.303927839e-02f,4.109803215e-02f,2.311557345e-02f,1.299963426e-02f,7.310371846e-03f,4.110949114e-03f,2.311761258e-03f,9.906073809e-01f,9.998233318e-01f,-9.596053362e-01f,6.067785621e-01f,9.854497313e-01f,7.084347010e-01f,4.283977747e-01f,2.463953048e-01f,1.395431161e-01f,7.864648104e-02f,4.425742477e-02f,2.489333972e-02f,1.399954315e-02f,7.872696966e-03f,4.427174106e-03f,2.489588689e-03f,6.502878666e-01f,8.358382583e-01f,-9.995186925e-01f,4.566033483e-01f,9.974949956e-01f,7.469826341e-01f,4.567528665e-01f,2.635899782e-01f,1.494381279e-01f,8.425120264e-02f,4.741637781e-02f,2.667102776e-02f,1.499943808e-02f,8.435019292e-03f,4.743398633e-03f,2.667415887e-03f,-2.879033089e-01f,4.144302309e-01f,-9.403103590e-01f,2.920270860e-01f,9.995735884e-01f,7.831690907e-01f,4.846512377e-01f,2.807013094e-01f,1.593182087e-01f,8.985326439e-02f,5.057485774e-02f,2.844863199e-02f,1.599931903e-02f,8.997339755e-03f,5.059622694e-03f,2.845243318e-03f,-9.613974690e-01f,-1.346147805e-01f,-7.878519297e-01f,1.182404235e-01f,9.916648269e-01f,8.168795705e-01f,5.120649934e-01f,2.977238595e-01f,1.691823453e-01f,9.545248002e-02f,5.373283103e-02f,3.022614680e-02f,1.699918136e-02f,9.559656493e-03f,5.375845823e-03f,3.023070283e-03f,-7.509872317e-01f,-6.422008872e-01f,-5.572627187e-01f,-5.927548930e-02f,9.738476276e-01f,8.480075002e-01f,5.389667153e-01f,3.146522641e-01f,1.790295690e-01f,1.010486782e-01f,5.689026415e-02f,3.200356290e-02f,1.799902879e-02f,1.012197044e-02f,5.692068953e-03f,3.200897481e-03f,1.498772055e-01f,-9.520007968e-01f,-2.714100778e-01f,-2.349218726e-01f,9.463000894e-01f,8.764545321e-01f,5.653295517e-01f,3.314811885e-01f,1.888588965e-01f,1.066416800e-01f,6.004713103e-02f,3.378088027e-02f,1.899885759e-02f,1.068428159e-02f,6.008291151e-03f,3.378724447e-03f,9.129452705e-01f,-9.686018229e-01f,4.135817289e-02f,-4.031589329e-01f,9.092974067e-01f,9.021307230e-01f,5.911270976e-01f,3.482052684e-01f,1.986693293e-01f,1.122313142e-01f,6.320339441e-02f,3.555808961e-02f,1.999866776e-02f,1.124658901e-02f,6.324512884e-03f,3.556551412e-03f,8.366556168e-01f,-6.868911386e-01f,3.500249386e-01f,-5.586805344e-01f,8.632093668e-01f,9.249548316e-01f,6.163335443e-01f,3.648192585e-01f,2.084598988e-01f,1.178173944e-01f,6.635902822e-02f,3.733518720e-02f,2.099845745e-02f,1.180889271e-02f,6.640734151e-03f,3.734378144e-03f,-8.851309307e-03f,-1.936304569e-01f,6.239799261e-01f,-6.965816617e-01f,8.084963560e-01f,9.448547959e-01f,6.409237385e-01f,3.813178837e-01f,2.182296216e-01f,1.233997494e-01f,6.951399893e-02f,3.911216930e-02f,2.199822664e-02f,1.237119269e-02f,6.956954487e-03f,3.912204877e-03f,-8.462204337e-01f,3.592648506e-01f,8.360552192e-01f,-8.125128746e-01f,7.457051873e-01f,9.617676139e-01f,6.648730040e-01f,3.976959288e-01f,2.279775143e-01f,1.289782077e-01f,7.266827673e-02f,4.088902473e-02f,2.299797349e-02f,1.293348894e-02f,7.273174357e-03f,4.090031143e-03f,-9.055783749e-01f,8.015131354e-01f,9.652193189e-01f,-9.028178453e-01f,6.754631400e-01f,9.756398797e-01f,6.881574988e-01f,4.139482081e-01f,2.377026230e-01f,1.345525682e-01f,7.582182437e-02f,4.266574979e-02f,2.399769798e-02f,1.349578146e-02f,7.589393295e-03f,4.267857410e-03f,-1.323517561e-01f,9.969099760e-01f,9.986631870e-01f,-9.646483660e-01f,5.984721184e-01f,9.864277244e-01f,7.107539177e-01f,4.300695956e-01f,2.474039495e-01f,1.401226968e-01f,7.897461206e-02f,4.444234446e-02f,2.499739639e-02f,1.405806933e-02f,7.905611768e-03f,4.445683677e-03f,7.625584602e-01f,8.852766752e-01f,9.330702424e-01f,-9.960542917e-01f,5.155013204e-01f,9.940969944e-01f,7.326396108e-01f,4.460549653e-01f,2.570805550e-01f,1.456883848e-01f,8.212661743e-02f,4.621879384e-02f,2.599707246e-02f,1.462035254e-02f,8.221829310e-03f,4.623509943e-03f,9.563759565e-01f,5.009943247e-01f,7.749451399e-01f,-9.960451722e-01f,4.273798466e-01f,9.986234903e-01f,7.537927032e-01f,4.618993104e-01f,2.667314410e-01f,1.512494683e-01f,8.527779579e-02f,4.799509794e-02f,2.699672058e-02f,1.518263202e-02f,8.538045920e-03f,4.801335745e-03f,2.709057927e-01f,-3.758518398e-02f,5.399692655e-01f,-9.646212459e-01f,3.349881172e-01f,9.999929070e-01f,7.741920948e-01f,4.775975943e-01f,2.763556540e-01f,1.568057686e-01f,8.842812479e-02f,4.977125302e-02f,2.799634263e-02f,1.574490592e-02f,8.854261599e-03f,4.979161546e-03f,-6.636338830e-01f,-5.645891428e-01f,2.514448762e-01f,-9.027736187e-01f,2.392492890e-01f,9.982009530e-01f,7.938173413e-01f,4.931448400e-01f,2.859522104e-01f,1.623571068e-01f,9.157756716e-02f,5.154724792e-02f,2.899593674e-02f,1.630717516e-02f,9.170476347e-03f,5.156987347e-03f,-9.880316257e-01f,-9.177098870e-01f,-6.201513484e-02f,-8.124529719e-01f,1.411199570e-01f,9.932531714e-01f,8.126488924e-01f,5.085361600e-01f,2.955201864e-01f,1.679033041e-01f,9.472609311e-02f,5.332308263e-02f,2.999550104e-02f,1.686943881e-02f,9.486690164e-03f,5.334812682e-03f,-4.040376544e-01f,-9.881927371e-01f,-3.693251312e-01f,-6.965078712e-01f,4.158061743e-02f,9.851652980e-01f,8.306677938e-01f,5.237666368e-01f,3.050586283e-01f,1.734442115e-01f,9.787367284e-02f,5.509874597e-02f,3.099503741e-02f,1.743169688e-02f,9.802903049e-03f,5.512638018e-03f,5.514267087e-01f,-7.543302178e-01f,-6.400094032e-01f,-5.585952997e-01f,-5.837419257e-02f,9.739628434e-01f,8.478561044e-01f,5.388315320e-01f,3.145665526e-01f,1.789796203e-01f,1.010202691e-01f,5.687423423e-02f,3.199454024e-02f,1.799395122e-02f,1.011911593e-02f,5.690463353e-03f,9.999118447e-01f,-2.881477177e-01f,-8.472242355e-01f,-4.030648470e-01f,-1.577457488e-01f,9.596813321e-01f,8.641966581e-01f,5.537260175e-01f,3.240430355e-01f,1.845093668e-01f,1.041658595e-01f,5.864954740e-02f,3.299401328e-02f,1.855619811e-02f,1.043532696e-02f,5.868288223e-03f,5.290827155e-01f,2.667790353e-01f,-9.704203606e-01f,-2.348219305e-01f,-2.555411458e-01f,9.423657656e-01f,8.796730638e-01f,5.684453845e-01f,3.334870934e-01f,1.900332868e-01f,1.073104069e-01f,6.042467058e-02f,3.399345279e-02f,1.911843941e-02f,1.075153705e-02f,6.046113092e-03f,-4.281826615e-01f,7.395427227e-01f,-9.973804355e-01f,-5.917284265e-02f,-3.507832885e-01f,9.220710397e-01f,8.942698836e-01f,5.829849839e-01f,3.428978026e-01f,1.955511868e-01f,1.104538813e-01f,6.219960377e-02f,3.499285504e-02f,1.968067512e-02f,1.106774528e-02f,6.223937497e-03f,-9.917788506e-01f,9.845407009e-01f,-9.254308343e-01f,1.183425263e-01f,-4.425204992e-01f,8.988611698e-01f,9.079725146e-01f,5.973402858e-01f,3.522742391e-01f,2.010629177e-01f,1.135962531e-01f,6.397434324e-02f,3.599222749e-02f,2.024290338e-02f,1.138395350e-02f,6.401761901e-03f,-6.435381174e-01f,9.263180494e-01f,-7.617068291e-01f,2.921254337e-01f,-5.298361778e-01f,8.728096485e-01f,9.207672477e-01f,6.115067005e-01f,3.616154194e-01f,2.065682858e-01f,1.167374924e-01f,6.574887782e-02f,3.699155897e-02f,2.080512606e-02f,1.170015987e-02f,6.579586305e-03f,2.963685691e-01f,5.828063488e-01f,-5.224447250e-01f,4.566948116e-01f,-6.118579507e-01f,8.439987302e-01f,9.326412678e-01f,6.254796982e-01f,3.709204495e-01f,2.120671123e-01f,1.198775545e-01f,6.752320379e-02f,3.799085692e-02f,2.136734314e-02f,1.201636530e-02f,6.757410243e-03f,9.637953639e-01f,5.980091169e-02f,-2.313721031e-01f,6.068602800e-01f,-6.877661943e-01f,8.125196099e-01f,9.435827732e-01f,6.392549276e-01f,3.801884055e-01f,2.175592482e-01f,1.230164245e-01f,6.929731369e-02f,3.899011761e-02f,2.192955278e-02f,1.233256981e-02f,6.935234182e-03f,7.451131344e-01f,-4.816221297e-01f,8.264556527e-02f,7.378856540e-01f,-7.568025589e-01f,7.784717679e-01f,9.535807371e-01f,6.528280377e-01f,3.894183338e-01f,2.230444849e-01f,1.261540651e-01f,7.107120752e-02f,3.998933733e-02f,2.249175496e-02f,1.264877338e-02f,7.113057654e-03f,-1.586226672e-01f,-8.747143149e-01f,3.884673417e-01f,8.456384540e-01f,-8.182771206e-01f,7.419627905e-01f,9.626252055e-01f,6.661946774e-01f,3.986093104e-01f,2.285226882e-01f,1.292904466e-01f,7.284487784e-02f,4.098851606e-02f,2.305395156e-02f,1.296497509e-02f,7.290881127e-03f,-9.165215492e-01f,-9.984104633e-01f,6.557649970e-01f,9.267202020e-01f,-8.715758324e-01f,7.031081319e-01f,9.707071185e-01f,6.793506145e-01f,4.077604413e-01f,2.339936495e-01f,1.324255317e-01f,7.461831719e-02f,4.198765382e-02f,2.361613885e-02f,1.328117494e-02f,7.468704134e-03f,-8.317747712e-01f,-8.146143556e-01f,8.580308557e-01f,9.785736799e-01f,-9.161659479e-01f,6.620306373e-01f,9.778184295e-01f,6.922917962e-01f,4.168708026e-01f,2.394572198e-01f,1.355592906e-01f,7.639151812e-02f,4.298675060e-02f,2.417832054e-02f,1.359737478e-02f,7.646527141e-03f,1.770192571e-02f,-3.799318373e-01f,9.752061963e-01f,9.995633364e-01f,-9.516021013e-01f,6.188601851e-01f,9.839519858e-01f,7.050140500e-01f,4.259394705e-01f,2.449132204e-01f,1.386916935e-01f,7.816448063e-02f,4.398580641e-02f,2.474049293e-02f,1.391357277e-02f,7.824349217e-03f,8.509035110e-01f,1.717627496e-01f,9.956709743e-01f,9.890273213e-01f,-9.775301218e-01f,5.737332702e-01f,9.891016483e-01f,7.175133228e-01f,4.349655211e-01f,2.503614724e-01f,1.418227106e-01f,7.993719727e-02f,4.498481750e-02f,2.530265786e-02f,1.422976889e-02f,8.002172224e-03f,9.017883539e-01f,6.705575585e-01f,9.173955917e-01f,9.472977519e-01f,-9.936910272e-01f,5.267924666e-01f,9.932623506e-01f,7.297857404e-01f,4.439480901e-01f,2.558017969e-01f,1.449523121e-01f,8.170966059e-02f,4.598378018e-02f,2.586481534e-02f,1.454596408e-02f,8.179994300e-03f,1.235731244e-01f,9.628328085e-01f,7.481426001e-01f,8.756909370e-01f,-9.999232292e-01f,4.781862795e-01f,9.964298010e-01f,7.418274283e-01f,4.528862834e-01f,2.612340450e-01f,1.480804533e-01f,8.348186314e-02f,4.698270187e-02f,2.642696351e-02f,1.486215740e-02f,8.357815444e-03f,-7.682546377e-01f,9.585731030e-01f,5.046967268e-01f,7.764651775e-01f,-9.961646199e-01f,4.280683398e-01f,9.986009598e-01f,7.536344528e-01f,4.617791772e-01f,2.666580379e-01f,1.512071192e-01f,8.525379747e-02f,4.798157141e-02f,2.698910423e-02f,1.517834980e-02f,8.535637520e-03f,-9.537526369e-01f,6.590903401e-01f,2.112003416e-01f,6.527500749e-01f,-9.824525714e-01f,3.765970767e-01f,9.997735620e-01f,7.652032375e-01f,4.706258774e-01f,2.720735967e-01f,1.543322802e-01f,8.702547103e-02f,4.898039624e-02f,2.755123749e-02f,1.549454033e-02f,8.713458665e-03f,-2.623748481e-01f,1.566197872e-01f,-1.032406390e-01f,5.084475875e-01f,-9.589242339e-01f,3.239352107e-01f,9.999465346e-01f,7.765299678e-01f,4.794255197e-01f,2.774805427e-01f,1.574558914e-01f,8.879686147e-02f,4.997917265e-02f,2.811335959e-02f,1.581072994e-02f,8.891279809e-03f,6.702291965e-01f,-3.940868378e-01f,-4.074433148e-01f,3.481088877e-01f,-9.258146286e-01f,2.702492476e-01f,9.991195798e-01f,7.876111865e-01f,4.881772399e-01f,2.828786969e-01f,1.605779380e-01f,9.056797624e-02f,5.097789690e-02f,2.867547423e-02f,1.612691581e-02f,9.069100954e-03f,9.866275787e-01f,-8.234218955e-01f,-6.712400317e-01f,1.767909825e-01f,-8.834546208e-01f,2.157088965e-01f,9.972936511e-01f,7.984433770e-01f,4.968801141e-01f,2.882679403e-01f,1.636983752e-01f,9.233880043e-02f,5.197657272e-02f,2.923758142e-02f,1.644310169e-02f,9.246921167e-03f,3.959251642e-01f,-9.991579652e-01f,-8.684703112e-01f,-1.028269617e-04f,-8.322674036e-01f,1.604866087e-01f,9.944704771e-01f,8.090230227e-01f,5.055333376e-01f,2.936480343e-01f,1.668171585e-01f,9.410934150e-02f,5.297519267e-02f,2.979967743e-02f,1.675928570e-02f,9.424741380e-03f,-5.587890744e-01f,-8.671716452e-01f,-9.795747995e-01f,-1.769933850e-01f,-7.727644444e-01f,1.047569439e-01f,9.906529188e-01f,8.193469048e-01f,5.141359568e-01f,2.990188599e-01f,1.699342877e-01f,9.587957710e-02f,5.397376418e-02f,3.036176413e-02f,1.707546972e-02f,9.602561593e-03f,-9.997551441e-01f,-4.681122005e-01f,-9.935354590e-01f,-3.483016491e-01f,-7.055402398e-01f,4.869610071e-02f,9.858447313e-01f,8.294116855e-01f,5.226871967e-01f,3.043802381e-01f,1.730497181e-01f,9.764950722e-02f,5.497227609e-02f,3.092384152e-02f,1.739165001e-02f,9.780380875e-03f,-5.215510130e-01f,7.511726022e-02f,-9.089677334e-01f,-5.086246729e-01f,-6.312665939e-01f,-7.518695667e-03f,9.800508618e-01f,8.392141461e-01f,5.311861634e-01f,3.097319901e-01f,1.761634201e-01f,9.941913933e-02f,5.597073957e-02f,3.148590773e-02f,1.770782843e-02f,9.958200157e-03f,4.361647666e-01f,5.952119827e-01f,-7.342582345e-01f,-6.529058814e-01f,-5.506854653e-01f,-6.370972097e-02f,9.732770324e-01f,8.487512469e-01f,5.396320224e-01f,3.150739372e-01f,1.792753637e-01f,1.011884436e-01f,5.696914345e-02f,3.204796463e-02f,1.802400686e-02f,1.013601944e-02f,9.928726554e-01f,9.319922328e-01f,-4.867327213e-01f,-7.765947580e-01f,-4.646021128e-01f,-1.196993291e-01f,9.655299187e-01f,8.580199480e-01f,5.480239391e-01f,3.204059303e-01f,1.823855042e-01f,1.029574350e-01f,5.796748772e-02f,3.261001408e-02f,1.834018156e-02f,1.031383779e-02f,6.367380023e-01f,9.817358851e-01f,-1.909382045e-01f,-8.757901788e-01f,-3.738765717e-01f,-1.753105223e-01f,9.568174481e-01f,8.670173287e-01f,5.563610196e-01f,3.257277906e-01f,1.854938269e-01f,1.047261059e-01f,5.896577984e-02f,3.317204863e-02f,1.865635440e-02f,1.049165614e-02f,-3.048106134e-01f,7.291227579e-01f,1.237915382e-01f,-9.473636150e-01f,-2.794153988e-01f,-2.303674668e-01f,9.471482038e-01f,8.757405877e-01f,5.646424890e-01f,3.310393393e-01f,1.886002868e-01f,1.064944416e-01f,5.996400863e-02f,3.373407573e-02f,1.897252724e-02f,1.066947356e-02f,-9.661177993e-01f,2.519530654e-01f,4.262449443e-01f,-9.890576601e-01f,-1.821624190e-01f,-2.846961319e-01f,9.365319014e-01f,8.841868639e-01f,5.728674531e-01f,3.363404274e-01f,1.917048693e-01f,1.082624346e-01f,6.096218154e-02f,3.429609165e-02f,1.928869635e-02f,1.084729191e-02f,-7.391806841e-01f,-3.028135300e-01f,6.864278913e-01f,-9.995572567e-01f,-8.308931440e-02f,-3.381247520e-01f,9.249790907e-01f,8.923535943e-01f,5.810351372e-01f,3.416308761e-01f,1.948075294e-01f,1.100300923e-01f,6.196028739e-02f,3.485809639e-02f,1.960486546e-02f,1.102510933e-02f,1.673557013e-01f,-7.643191218e-01f,8.785381913e-01f,-9.785313010e-01f,1.681399345e-02f,-3.904843926e-01f,9.125014544e-01f,9.002380967e-01f,5.891447663e-01f,3.469105065e-01f,1.979082376e-01f,1.117973998e-01f,6.295833737e-02f,3.542008996e-02f,1.992103085e-02f,1.120292582e-02f};
namespace pg8 {
#define PG8_LAS __attribute__((address_space(3)))
typedef unsigned short bf16_t;
typedef short bf16x8 __attribute__((ext_vector_type(8)));
typedef float f32x4 __attribute__((ext_vector_type(4)));
typedef unsigned u32x4 __attribute__((ext_vector_type(4)));
constexpr int BM = 256, BK = 64, HALF = 128, HTB = HALF * BK * 2  , STAGE_BYTES = 8 * HTB, NXCD = 8, WGM = 8;

__host__ __device__ __forceinline__ int lds_byte(int r, int c) { const int st = (r >> 4) * 2 + (c >> 5), rr = r & 15, cc = c & 31, ob = rr * 64 + cc * 2; return st * 1024 + (ob ^ (((ob >> 9) & 1) << 5)); }
__host__ __device__ __forceinline__ void stage_rc(int b, int& R, int& C) { const int st = b / 1024, sb = b % 1024, swz = sb ^ (((sb >> 9) & 1) << 5); R = (st >> 1) * 16 + swz / 64; C = (st & 1) * 32 + (swz % 64) / 2; }
__host__ __device__ __forceinline__ int perm32(int rho) { const int n = rho >> 4, i = rho & 15; return 8 * (i >> 2) + 4 * n + (i & 3); }

struct Unit { int pm, pn, kb, nt; };
struct Gemm { const bf16_t* A; const bf16_t* Bt; int M, N, K; };

struct StaticOrder {
    int nM, nN, nwg, G, c, ntf;
    __host__ __device__ void init(int M, int N, int G_, int c_, int K_ = 1024) { nM = M / BM; nN = N / BM; nwg = nM * nN; G = G_; c = c_; ntf = K_ / BK; }
    __host__ __device__ bool next(int i, Unit& u) const {
        const long L = (long)i * G + c; if (L >= nwg) return false;
        int wgid = (int)L; { const int q = nwg / NXCD, r = nwg % NXCD, xcd = wgid % NXCD, off = wgid / NXCD; wgid = (xcd < r ? xcd * (q + 1) : r * (q + 1) + (xcd - r) * q) + off; }
        const int nig = WGM * nN, gid = wgid / nig, fm = gid * WGM, gsz = (nM - fm) < WGM ? (nM - fm) : WGM;
        u.pm = fm + ((wgid % nig) % gsz); u.pn = (wgid % nig) / gsz; u.kb = 0; u.nt = ntf; return true;
    }
    __device__ __forceinline__ void a_ready(const Unit&) const {}
    __device__ __forceinline__ void done(const Unit&) const {}
};
__device__ __forceinline__ unsigned cvt_pk_bf16(float lo, float hi) { unsigned r; asm volatile("v_cvt_pk_bf16_f32 %0, %1, %2" : "=v"(r) : "v"(lo), "v"(hi)); return r; }
typedef float f32x2 __attribute__((ext_vector_type(2)));
template <class Epi, class Sched, bool ALIGN_EPI = false, bool SP2 = false>
__device__ __forceinline__ void gemm_phase(PG8_LAS unsigned char* lds, const Gemm g, const Sched& S, const Epi& E) {
    int tid_ = threadIdx.x; asm volatile("" : "+v"(tid_)); const int tid = tid_, wid = __builtin_amdgcn_readfirstlane(tid >> 6), lane = tid & 63, wr = wid >> 2, wc = wid & 3, fr = lane & 15, fq = lane >> 4;
    const int K = g.K;
    unsigned voffA[2], voffB[2];
#pragma unroll
    for (int i = 0; i < 2; ++i) { int R, C; stage_rc(tid * 16 + i * 8192, R, C); const int Rb = Epi::PERM ? ((R & ~31) + perm32(R & 31)) : R;
        voffA[i] = (unsigned)(R * K + C) * 2u; voffB[i] = (unsigned)(Rb * K + C) * 2u; }
    const size_t kstep = (size_t)(BK * 2);
    const size_t hstep = (size_t)HALF * K * 2;
    const size_t tstep = 2 * hstep;
    const unsigned ldsw = (unsigned)wid * 1024u;
    const int aoff = lds_byte(wr * 64 + fr, fq * 8), boff = lds_byte(wc * 32 + fr, fq * 8);
#define PG8_SA(b, h) (((b) * 2 + (h)) * HTB)
#define PG8_SB(b, h) ((4 + (b) * 2 + (h)) * HTB)
#define PG8_STAGE(bufoff, gbase, voff) do { _Pragma("unroll") for (int _i = 0; _i < 2; ++_i) \
        __builtin_amdgcn_global_load_lds((const unsigned*)((const char*)(gbase) + (voff)[_i]), (PG8_LAS unsigned*)(lds + (bufoff) + ldsw + _i * 8192), 16, 0, 0); } while (0)
#define PG8_LDA(dst, b, h) do { _Pragma("unroll") for (int m = 0; m < 4; ++m) _Pragma("unroll") for (int k = 0; k < 2; ++k) dst[m][k] = *(const PG8_LAS bf16x8*)(lds + PG8_SA(b, h) + aoff + m * 2048 + k * 1024); } while (0)
#define PG8_LDB(dst, b, h) do { _Pragma("unroll") for (int n = 0; n < 2; ++n) _Pragma("unroll") for (int k = 0; k < 2; ++k) dst[n][k] = *(const PG8_LAS bf16x8*)(lds + PG8_SB(b, h) + boff + n * 2048 + k * 1024); } while (0)
#define PG8_MMA(ai, bj, At, Bt) do { __builtin_amdgcn_s_setprio(1); _Pragma("unroll") for (int m = 0; m < 4; ++m) _Pragma("unroll") for (int n = 0; n < 2; ++n) _Pragma("unroll") for (int k = 0; k < 2; ++k) \
        acc[ai][bj][m][n] = __builtin_amdgcn_mfma_f32_16x16x32_bf16(Bt[n][k], At[m][k], acc[ai][bj][m][n], 0, 0, 0); __builtin_amdgcn_s_setprio(0); } while (0)
#define PG8_WAIT_V(n) asm volatile("s_waitcnt vmcnt(" #n ")" ::: "memory")
#define PG8_WAIT_L(n) asm volatile("s_waitcnt lgkmcnt(" #n ")" ::: "memory")
#define PG8_BAR __builtin_amdgcn_s_barrier()
#define PG8_SCHED __builtin_amdgcn_sched_barrier(0)
    Unit cur, nxt; int ui = 0;
    if (!S.next(0, cur)) return;
    f32x4 acc[2][2][4][2];
#pragma unroll
    for (int a = 0; a < 2; ++a)
#pragma unroll
        for (int b = 0; b < 2; ++b)
#pragma unroll
            for (int m = 0; m < 4; ++m)
#pragma unroll
                for (int n = 0; n < 2; ++n) acc[a][b][m][n] = (f32x4){0.f, 0.f, 0.f, 0.f};
    bf16x8 At[4][2], B0[2][2], B1[2][2];
    const char* cA = (const char*)g.A + (size_t)cur.pm * tstep + (size_t)cur.kb * kstep; const char* cB = (const char*)g.Bt + (size_t)cur.pn * tstep + (size_t)cur.kb * kstep;
    S.a_ready(cur);
    if constexpr (SP2) {
        PG8_STAGE(PG8_SB(0, 0), cB, voffB); PG8_STAGE(PG8_SB(0, 1), cB + hstep, voffB); PG8_STAGE(PG8_SA(0, 0), cA, voffA); PG8_STAGE(PG8_SA(0, 1), cA + hstep, voffA);
        if (wr == 1) PG8_BAR;
        PG8_WAIT_V(2); PG8_BAR;
        PG8_STAGE(PG8_SB(1, 0), cB + kstep, voffB); PG8_STAGE(PG8_SA(1, 0), cA + kstep, voffA); PG8_STAGE(PG8_SB(1, 1), cB + hstep + kstep, voffB);
        PG8_WAIT_V(6); PG8_BAR;
    } else {
        PG8_STAGE(PG8_SB(0, 0), cB, voffB); PG8_STAGE(PG8_SA(0, 0), cA, voffA); PG8_STAGE(PG8_SB(0, 1), cB + hstep, voffB); PG8_STAGE(PG8_SA(0, 1), cA + hstep, voffA);
        if (wr == 1) PG8_BAR;
        PG8_WAIT_V(4); PG8_BAR;
        PG8_STAGE(PG8_SB(1, 0), cB + kstep, voffB); PG8_STAGE(PG8_SA(1, 0), cA + kstep, voffA); PG8_STAGE(PG8_SB(1, 1), cB + hstep + kstep, voffB);
        PG8_WAIT_V(6); PG8_BAR;
    }
    for (;;) {
        const bool has_next = S.next(ui + 1, nxt);
        const char* nA = has_next ? (const char*)g.A + (size_t)nxt.pm * tstep + (size_t)nxt.kb * kstep : cA; const char* nB = has_next ? (const char*)g.Bt + (size_t)nxt.pn * tstep + (size_t)nxt.kb * kstep : cB;
        const int nt = cur.nt;
        for (int t = 0; t < nt; t += 2) {
            const bool last = (t == nt - 2);
            const char* a1 = cA + (size_t)(t + 1) * kstep;
            const char* a2 = last ? nA : cA + (size_t)(t + 2) * kstep; const char* b2 = last ? nB : cB + (size_t)(t + 2) * kstep;
            const char* a3 = a2 + kstep; const char* b3 = b2 + kstep;
            if (last && has_next) S.a_ready(nxt);
            if constexpr (SP2) {
            PG8_LDB(B0, 0, 0); PG8_LDB(B1, 0, 1); PG8_SCHED; PG8_LDA(At, 0, 0); PG8_STAGE(PG8_SA(1, 1), a1 + hstep, voffA);
            PG8_WAIT_V(8); PG8_WAIT_L(0); PG8_BAR; PG8_MMA(0, 0, At, B0); PG8_MMA(0, 1, At, B1); PG8_BAR; PG8_SCHED;
            PG8_LDA(At, 0, 1); PG8_STAGE(PG8_SB(0, 0), b2, voffB); PG8_STAGE(PG8_SB(0, 1), b2 + hstep, voffB); PG8_STAGE(PG8_SA(0, 0), a2, voffA);
            PG8_WAIT_V(8); PG8_WAIT_L(0); PG8_BAR; PG8_MMA(1, 0, At, B0); PG8_MMA(1, 1, At, B1); PG8_BAR; PG8_SCHED;
            PG8_LDB(B0, 1, 0); PG8_LDB(B1, 1, 1); PG8_SCHED; PG8_LDA(At, 1, 0); PG8_STAGE(PG8_SA(0, 1), a2 + hstep, voffA);
            PG8_WAIT_V(8); PG8_WAIT_L(0); PG8_BAR; PG8_MMA(0, 0, At, B0); PG8_MMA(0, 1, At, B1); PG8_BAR; PG8_SCHED;
            PG8_LDA(At, 1, 1); PG8_STAGE(PG8_SB(1, 0), b3, voffB); PG8_STAGE(PG8_SB(1, 1), b3 + hstep, voffB); PG8_STAGE(PG8_SA(1, 0), a3, voffA);
            PG8_WAIT_V(8); PG8_WAIT_L(0); PG8_BAR; PG8_MMA(1, 0, At, B0); PG8_MMA(1, 1, At, B1); PG8_BAR; PG8_SCHED;
            } else {
            PG8_LDB(B0, 0, 0); PG8_SCHED; PG8_LDA(At, 0, 0); PG8_STAGE(PG8_SA(1, 1), a1 + hstep, voffA);
            PG8_WAIT_L(8); PG8_BAR; PG8_WAIT_L(0); PG8_MMA(0, 0, At, B0); PG8_BAR; PG8_SCHED;
            PG8_LDB(B1, 0, 1); PG8_STAGE(PG8_SB(0, 0), b2, voffB);
            PG8_BAR; PG8_WAIT_L(0); PG8_MMA(0, 1, At, B1); PG8_BAR;
            PG8_LDA(At, 0, 1); PG8_STAGE(PG8_SA(0, 0), a2, voffA);
            PG8_BAR; PG8_WAIT_L(0); PG8_MMA(1, 0, At, B0); PG8_BAR; PG8_SCHED;
            PG8_STAGE(PG8_SB(0, 1), b2 + hstep, voffB);
            PG8_WAIT_V(6); PG8_BAR; PG8_MMA(1, 1, At, B1); PG8_BAR;
            PG8_LDB(B0, 1, 0); PG8_SCHED; PG8_LDA(At, 1, 0); PG8_STAGE(PG8_SA(0, 1), a2 + hstep, voffA);
            PG8_WAIT_L(8); PG8_BAR; PG8_WAIT_L(0); PG8_MMA(0, 0, At, B0); PG8_BAR; PG8_SCHED;
            PG8_LDB(B1, 1, 1); PG8_STAGE(PG8_SB(1, 0), b3, voffB);
            PG8_BAR; PG8_WAIT_L(0); PG8_MMA(0, 1, At, B1); PG8_BAR;
            PG8_LDA(At, 1, 1); PG8_STAGE(PG8_SA(1, 0), a3, voffA);
            PG8_BAR; PG8_WAIT_L(0); PG8_MMA(1, 0, At, B0); PG8_BAR; PG8_SCHED;
            PG8_STAGE(PG8_SB(1, 1), b3 + hstep, voffB);
            PG8_WAIT_V(6); PG8_BAR; PG8_MMA(1, 1, At, B1); PG8_BAR;
            }
        }
        if constexpr (ALIGN_EPI) { if (wr == 0) PG8_BAR; }
        if constexpr (!Epi::AFTER_DRAIN) { E(acc, cur, wr, wc, fr, fq); S.done(cur); }
        if (!has_next) break;
#pragma unroll
        for (int a = 0; a < 2; ++a)
#pragma unroll
            for (int b = 0; b < 2; ++b)
#pragma unroll
                for (int m = 0; m < 4; ++m)
#pragma unroll
                    for (int n = 0; n < 2; ++n) acc[a][b][m][n] = (f32x4){0.f, 0.f, 0.f, 0.f};
        cur = nxt; cA = nA; cB = nB; ++ui;
        if constexpr (ALIGN_EPI) { if (wr == 1) PG8_BAR; }
    }
    PG8_WAIT_V(0);
    if constexpr (!ALIGN_EPI) { if (wr == 0) PG8_BAR; }
    PG8_BAR;
    if constexpr (Epi::AFTER_DRAIN) { E.fused(acc, cur, wr, wc, fr, fq, lds, wid, lane); S.done(cur); }
#undef PG8_SA
#undef PG8_SB
#undef PG8_STAGE
#undef PG8_LDA
#undef PG8_LDB
#undef PG8_MMA
#undef PG8_WAIT_V
#undef PG8_WAIT_L
#undef PG8_BAR
#undef PG8_SCHED
}
}
#define LAS __attribute__((address_space(3)))
typedef unsigned short bf16;
typedef short bf16x8 __attribute__((ext_vector_type(8)));
typedef short s16x4 __attribute__((ext_vector_type(4)));
typedef float f32x4 __attribute__((ext_vector_type(4)));
typedef unsigned u32x2 __attribute__((ext_vector_type(2)));
typedef unsigned u32x4 __attribute__((ext_vector_type(4)));

constexpr int DM = 1024, NBATCH = 16, SEQ = 4096, DEPTH = 4, CTXL = 256, FF = 4096;
constexpr int ML = NBATCH * SEQ, MCX = NBATCH * CTXL, MT = ML + MCX;
constexpr int NP = 2816, NINP = 3072, NSM = 48, NINSRC = 2864;
constexpr float EPS = 1e-6f;
constexpr int NT = 512, NWAVES = 8;
constexpr int LDS_BYTES = 147456;
constexpr int LT = 72;
constexpr int TB = 64 * LT * 2;
constexpr int NGRP = 17;
constexpr int MST_TILE = 65 * 64;

constexpr size_t MiB = 1u << 20;
constexpr size_t WS_WIN = 0, WS_WOUT = 24 * MiB, WS_W1 = 32 * MiB, WS_W2 = 64 * MiB, WS_MOD = 96 * MiB, WS_SM = 98 * MiB, WS_XC = 112 * MiB,
                 WS_H = 128 * MiB, WS_P = 264 * MiB, WS_MST = 638 * MiB, WS_GST = 778 * MiB, WS_MSC = 914 * MiB, WS_GDEC = 915 * MiB, WS_PART = 920 * MiB, WS_END = 984 * MiB;
constexpr size_t WS_HID = WS_P;
constexpr size_t WS_BAR = WS_MSC + 512 * 1024;
static_assert(WS_HID + (size_t)MT * FF * 2 <= WS_MSC, "hidden overlay");
static_assert(WS_P + (size_t)MT * NP * 2 <= WS_MST && WS_MST + (size_t)512 * NGRP * MST_TILE * 4 <= WS_GST && WS_GST + (size_t)512 * NGRP * 4096 * 4 <= WS_MSC, "ws map");

__device__ __forceinline__ unsigned f2bf(float f) { unsigned u = __builtin_bit_cast(unsigned, f); return (u + 0x7fffu + ((u >> 16) & 1u)) >> 16; }
__device__ __forceinline__ unsigned pk2(float lo, float hi) { return pg8::cvt_pk_bf16(lo, hi); }
__device__ __forceinline__ float bf2f(bf16 v) { return __builtin_bit_cast(float, ((unsigned)v) << 16); }
__device__ __forceinline__ float bfs2f(short v) { return __builtin_bit_cast(float, ((unsigned)(unsigned short)v) << 16); }
__device__ __forceinline__ float fexp(float x) { return __builtin_amdgcn_exp2f(x * 1.4426950408889634f); }
__device__ __forceinline__ float logsigmoidf(float x) { return fminf(x, 0.f) - log1pf(expf(-fabsf(x))); }
__device__ __forceinline__ float sigmoidf_(float x) { return __builtin_amdgcn_rcpf(1.f + fexp(-x)); }
__device__ __forceinline__ float logsigmoid_fast(float x) { return -0.6931471805599453f * __builtin_amdgcn_logf(1.f + fexp(-x)); }
__device__ __forceinline__ float wave_sum(float v) {
#pragma unroll
    for (int o = 1; o < 64; o <<= 1) v += __shfl_xor(v, o);
    return v;
}
__device__ __forceinline__ float wave_max(float v) {
#pragma unroll
    for (int o = 1; o < 64; o <<= 1) v = fmaxf(v, __shfl_xor(v, o));
    return v;
}
#define LBAR() do { asm volatile("s_waitcnt lgkmcnt(0)" ::: "memory"); __builtin_amdgcn_s_barrier(); asm volatile("" ::: "memory"); } while (0)
#define MFMA16(a, b, c) __builtin_amdgcn_mfma_f32_16x16x32_bf16((a), (b), (c), 0, 0, 0)

__device__ __forceinline__ int in_srccol(int j) {
    if (j < 1792) return j;
    if (j < 2816) return j + 16;
    if (j < 2832) return j - 1024;
    if (j < 2864) return j;
    return -1;
}

struct EpiIn {
    static constexpr bool PERM = false, AFTER_DRAIN = false;
    bf16* P; float* SM; const float* mib; const float* mfb; const LAS float* rope;
    __device__ __forceinline__ void operator()(const f32x4 (&acc)[2][2][4][2], const pg8::Unit& u, int wr, int wc, int fr, int fq) const {
        const int pn = u.pn; const bool latent = u.pm < 256;
        const int rowb = u.pm * 256 + wr * 64 + fr;
        if (pn == 11) {
            if (wc < 2) {
#pragma unroll
                for (int ai = 0; ai < 2; ++ai)
#pragma unroll
                    for (int m = 0; m < 4; ++m) { const int row = rowb + ai * 128 + m * 16;
#pragma unroll
                        for (int n = 0; n < 2; ++n) { const int c = wc * 32 + n * 16 + 4 * fq;
                            if (c < 48) { f32x4 v = acc[ai][0][m][n];
                                if (c < 8) { v += *(const f32x4*)(mib + c); }
                                else if (c < 16) { v += *(const f32x4*)(mfb + c - 8); v[0] = logsigmoidf(v[0]); v[1] = logsigmoidf(v[1]); v[2] = logsigmoidf(v[2]); v[3] = logsigmoidf(v[3]); }
                                *(f32x4*)(SM + (size_t)row * NSM + c) = v; } } }
            }
            return;
        }
        int op = 0;
        if (pn < 2) op = 1; else if (pn == 2) op = 2; else if (pn == 4 || pn == 7) op = 3; else if (pn == 6) op = 4; else if (pn == 10) op = 5;
        const float sc = op == 1 ? 0.125f * 1.4426950408889634f : (op == 3 ? 0.125f : 1.f);
        const bool dorope = latent && (op == 1 || op == 2);
#pragma unroll
        for (int ai = 0; ai < 2; ++ai)
#pragma unroll
            for (int m = 0; m < 4; ++m) {
                const int row = rowb + ai * 128 + m * 16;
                f32x4 cs = {1.f, 1.f, 1.f, 1.f}, sn = {0.f, 0.f, 0.f, 0.f};
                if (dorope) { const int t = row & 4095; const int pos = (wc & 1) ? (t & 63) : (t >> 6);
                    cs = *(const LAS f32x4*)(rope + pos * 16 + 4 * fq); sn = *(const LAS f32x4*)(rope + 1024 + pos * 16 + 4 * fq); }
                bf16* rowp = P + (size_t)row * NP + pn * 256 + wc * 32 + 4 * fq;
#pragma unroll
                for (int bj = 0; bj < 2; ++bj) {
                    f32x4 x1 = acc[ai][bj][m][0], x2 = acc[ai][bj][m][1];
                    if (dorope && (op == 1 || bj == 0)) { const f32x4 o1 = x1 * cs - x2 * sn, o2 = x2 * cs + x1 * sn; x1 = o1; x2 = o2; }
                    x1 = x1 * sc; x2 = x2 * sc;
                    if (op == 4) {
#pragma unroll
                        for (int j = 0; j < 4; ++j) { x1[j] = sigmoidf_(x1[j]); x2[j] = sigmoidf_(x2[j]); } }
                    if (op == 5) {
#pragma unroll
                        for (int j = 0; j < 4; ++j) { x1[j] = x1[j] * sigmoidf_(x1[j]); x2[j] = x2[j] * sigmoidf_(x2[j]); } }
                    u32x2 w1, w2; w1.x = pk2(x1[0], x1[1]); w1.y = pk2(x1[2], x1[3]); w2.x = pk2(x2[0], x2[1]); w2.y = pk2(x2[2], x2[3]);
                    *(u32x2*)(rowp + bj * 128) = w1; *(u32x2*)(rowp + bj * 128 + 16) = w2;
                }
                asm volatile("" ::: "memory");
            }
    }
};

struct EpiRes {
    static constexpr bool PERM = false, AFTER_DRAIN = false;
    const float* srcL; const float* srcC; float* dstL; float* dstC; const float* gate;
    int nt_full; float* part;
    __device__ __forceinline__ void operator()(const f32x4 (&acc)[2][2][4][2], const pg8::Unit& u, int wr, int wc, int fr, int fq) const {
        const bool latent = u.pm < 256; const bool split = u.nt < nt_full;
        const int b = latent ? (u.pm >> 4) : 16;
        const float* src = latent ? srcL + (size_t)u.pm * 256 * DM : srcC + (size_t)(u.pm - 256) * 256 * DM;
        float* dst = latent ? dstL + (size_t)u.pm * 256 * DM : dstC + (size_t)(u.pm - 256) * 256 * DM;
        const int col0 = u.pn * 256 + wc * 32 + 4 * fq;
        const float* g = gate + (size_t)b * 6144 + col0;
#pragma unroll
        for (int bj = 0; bj < 2; ++bj)
#pragma unroll
            for (int n = 0; n < 2; ++n) { const f32x4 gv = *(const f32x4*)(g + bj * 128 + n * 16);
#pragma unroll
                for (int ai = 0; ai < 2; ++ai) {
#pragma unroll
                    for (int m = 0; m < 4; ++m) { const size_t off = (size_t)(ai * 128 + wr * 64 + m * 16 + fr) * DM + col0 + bj * 128 + n * 16;
                        if (split) { *(f32x4*)(part + (size_t)(u.kb / u.nt) * MCX * DM + (size_t)(u.pm - 256) * 256 * DM + off) = gv * acc[ai][bj][m][n]; }
                        else { const f32x4 sv = *(const f32x4*)(src + off);
                        *(f32x4*)(dst + off) = sv + gv * acc[ai][bj][m][n]; } } }
                asm volatile("" ::: "memory"); }
    }
};

struct EpiRelu2 {
    static constexpr bool PERM = true, AFTER_DRAIN = false;
    bf16* O;
    __device__ __forceinline__ void operator()(const f32x4 (&acc)[2][2][4][2], const pg8::Unit& u, int wr, int wc, int fr, int fq) const {
        const int row0 = u.pm * 256 + wr * 64 + fr, col0 = u.pn * 256 + wc * 32 + 8 * fq;
#pragma unroll
        for (int ai = 0; ai < 2; ++ai)
#pragma unroll
            for (int m = 0; m < 4; ++m) { bf16* rowp = O + (size_t)(row0 + ai * 128 + m * 16) * FF + col0;
#pragma unroll
                for (int bj = 0; bj < 2; ++bj) { f32x4 v0 = acc[ai][bj][m][0], v1 = acc[ai][bj][m][1];
#pragma unroll
                    for (int j = 0; j < 4; ++j) { const float a = fmaxf(v0[j], 0.f), c = fmaxf(v1[j], 0.f); v0[j] = a * a; v1[j] = c * c; }
                    u32x4 w; w.x = pk2(v0[0], v0[1]); w.y = pk2(v0[2], v0[3]); w.z = pk2(v1[0], v1[1]); w.w = pk2(v1[2], v1[3]);
                    *(u32x4*)(rowp + bj * 128) = w; } }
    }
};

struct SplitOrder : pg8::StaticOrder {
    __device__ bool next(int i, pg8::Unit& u) const {
        const long L = (long)i * G + c;
        if (L < 1024) return pg8::StaticOrder::next(i, u);
        const int r = (int)(L - 1024); if (r >= 256) return false;
        u.pm = 256 + (r >> 4); u.pn = (r >> 2) & 3; u.kb = (r & 3) * (ntf / 4); u.nt = ntf / 4; return true;
    }
};

struct Args { const float* in[20]; float* out; unsigned char* ws; };

struct Ctx {
    LAS unsigned char* lds; int tid, lane, wave, G, bid;
    const float* const* in;
    float* out; unsigned char* ws;
};

__device__ __forceinline__ void transpose_item(const float* W, int K, int N, bf16* WT, int Ndst, bool inmap, LAS float* scr, int item, int lane) {
    const int nblk = Ndst / 64, kb = item / nblk, nb = item % nblk, k0 = 64 * kb, n0 = 64 * nb;
    const int c4 = (lane & 15) * 4, rr = lane >> 4;
    int scol = n0 + c4; bool vec = true;
    if (inmap) { scol = in_srccol(n0 + c4); vec = (scol >= 0) && (in_srccol(n0 + c4 + 3) == scol + 3); }
#pragma unroll 8
    for (int i = 0; i < 16; ++i) { const int kk = 4 * i + rr; f32x4 v = {0.f, 0.f, 0.f, 0.f};
        if (vec) v = *(const f32x4*)(W + (size_t)(k0 + kk) * N + scol);
        else if (inmap) {
#pragma unroll
            for (int q = 0; q < 4; ++q) { const int sq = in_srccol(n0 + c4 + q); if (sq >= 0) v[q] = W[(size_t)(k0 + kk) * N + sq]; } }
        *(LAS f32x4*)(scr + kk * 68 + c4) = v; }
    asm volatile("s_waitcnt lgkmcnt(0)" ::: "memory");
    const int c = lane & 7;
#pragma unroll
    for (int j = 0; j < 8; ++j) { const int n = (lane >> 3) + 8 * j; const LAS float* sp = scr + (8 * c) * 68 + n;
        u32x4 o; o.x = pk2(sp[0 * 68], sp[1 * 68]); o.y = pk2(sp[2 * 68], sp[3 * 68]); o.z = pk2(sp[4 * 68], sp[5 * 68]); o.w = pk2(sp[6 * 68], sp[7 * 68]);
        *(u32x4*)(WT + (size_t)(n0 + n) * K + k0 + 8 * c) = o; }
    asm volatile("s_waitcnt lgkmcnt(0)" ::: "memory");
}

__device__ __forceinline__ void prologue(const Ctx& F) {
    {
        LAS float* sc = (LAS float*)F.lds;
        LAS float* red = (LAS float*)(F.lds + 1024 * 20 * 4);
        const float* c = F.in[1]; const float* cc = F.in[3];
        bool staged = false;
        for (int t = F.bid; t < 4 * 96; t += F.G) {
            if (!staged) {
                for (int i = F.tid; i < 17 * 1024; i += NT) { const float v = i < 16 * 1024 ? c[i] : cc[i - 16 * 1024]; sc[(i & 1023) * 20 + (i >> 10)] = v / (1.f + expf(-v)); }
                staged = true; __syncthreads();
            }
            const int l = t / 96, c0 = (t % 96) * 64;
            const float* W = F.in[4] + (size_t)l * DM * 6144;
            const int ks = F.tid >> 6, col = F.tid & 63;
            float acc[17];
#pragma unroll
            for (int b = 0; b < 17; ++b) acc[b] = 0.f;
#pragma unroll 8
            for (int k = ks * 128; k < ks * 128 + 128; ++k) { const float w = W[(size_t)k * 6144 + c0 + col];
                const f32x4 s0 = *(const LAS f32x4*)(sc + k * 20), s1 = *(const LAS f32x4*)(sc + k * 20 + 4), s2 = *(const LAS f32x4*)(sc + k * 20 + 8), s3 = *(const LAS f32x4*)(sc + k * 20 + 12);
                const float s16 = sc[k * 20 + 16];
#pragma unroll
                for (int q = 0; q < 4; ++q) { acc[q] += s0[q] * w; acc[4 + q] += s1[q] * w; acc[8 + q] += s2[q] * w; acc[12 + q] += s3[q] * w; }
                acc[16] += s16 * w; }
#pragma unroll
            for (int b = 0; b < 17; ++b) red[(ks * 17 + b) * 64 + col] = acc[b];
            __syncthreads();
            float* MOD = (float*)(F.ws + WS_MOD);
            for (int i = F.tid; i < 17 * 64; i += NT) { const int b = i >> 6, cl = i & 63; float s = F.in[5][(size_t)l * 6144 + c0 + cl];
#pragma unroll
                for (int k8 = 0; k8 < 8; ++k8) s += red[(k8 * 17 + b) * 64 + cl];
                MOD[((size_t)l * 17 + b) * 6144 + c0 + cl] = s; }
            __syncthreads();
        }
        __syncthreads();
    }
    {
        LAS float* scr = (LAS float*)(F.lds + F.wave * 17408);
        const int gw = F.bid * NWAVES + F.wave, NGW = F.G * NWAVES;
        constexpr int I_IN = (DM / 64) * (NINP / 64), I_O = (DM / 64) * (DM / 64), I_1 = (DM / 64) * (FF / 64), I_2 = (FF / 64) * (DM / 64);
        constexpr int PER_L = I_IN + I_O + I_1 + I_2;
        for (int it = gw; it < DEPTH * PER_L; it += NGW) {
            const int l = it / PER_L; int r = it % PER_L;
            if (r < I_IN) { transpose_item(F.in[8] + (size_t)l * DM * NINSRC, DM, NINSRC, (bf16*)(F.ws + WS_WIN) + (size_t)l * NINP * DM, NINP, true, scr, r, F.lane); continue; } r -= I_IN;
            if (r < I_O) { transpose_item(F.in[16] + (size_t)l * DM * DM, DM, DM, (bf16*)(F.ws + WS_WOUT) + (size_t)l * DM * DM, DM, false, scr, r, F.lane); continue; } r -= I_O;
            if (r < I_1) { transpose_item(F.in[17] + (size_t)l * DM * FF, DM, FF, (bf16*)(F.ws + WS_W1) + (size_t)l * FF * DM, FF, false, scr, r, F.lane); continue; } r -= I_1;
            transpose_item(F.in[18] + (size_t)l * FF * DM, FF, DM, (bf16*)(F.ws + WS_W2) + (size_t)l * DM * FF, DM, false, scr, r, F.lane);
        }
    }
}

__device__ __forceinline__ void norm_phase(const Ctx& F, const float* srcL, const float* srcC, const float* g, const float* mod  , int Meff, const float* part = nullptr, float* xcw = nullptr) {
    bf16* H = (bf16*)(F.ws + WS_H);
    constexpr int NR = 4;
    const int gw = F.bid * NWAVES + F.wave, NGW = F.G * NWAVES;
    for (int r = NR * gw; r < Meff; r += NR * NGW) {
        const bool latent = r < ML; const int b = latent ? (r >> 12) : 16;
        const float* xr = latent ? srcL + (size_t)r * DM : srcC + (size_t)(r - ML) * DM;
        const float* sh = mod + (size_t)b * 6144; const float* scl = sh + 1024;
        f32x4 v[NR][4];
#pragma unroll
        for (int q = 0; q < NR; ++q)
#pragma unroll
            for (int j = 0; j < 4; ++j) v[q][j] = *(const f32x4*)(xr + q * DM + 4 * F.lane + 256 * j);
        if (part && !latent) {
#pragma unroll
            for (int q = 0; q < NR; ++q)
#pragma unroll
                for (int j = 0; j < 4; ++j) { const size_t o = (size_t)(r + q - ML) * DM + 4 * F.lane + 256 * j;
                    v[q][j] = v[q][j] + ((*(const f32x4*)(part + o) + *(const f32x4*)(part + (size_t)MCX * DM + o)) + (*(const f32x4*)(part + (size_t)2 * MCX * DM + o) + *(const f32x4*)(part + (size_t)3 * MCX * DM + o)));
                    *(f32x4*)(xcw + o) = v[q][j]; }
        }
        float rstd[NR];
#pragma unroll
        for (int q = 0; q < NR; ++q) { float s = 0.f;
#pragma unroll
            for (int j = 0; j < 4; ++j) s += (v[q][j].x * v[q][j].x + v[q][j].y * v[q][j].y) + (v[q][j].z * v[q][j].z + v[q][j].w * v[q][j].w);
            rstd[q] = 1.f / sqrtf(wave_sum(s) * (1.f / DM) + EPS); }
#pragma unroll
        for (int j = 0; j < 4; ++j) { const int k = 4 * F.lane + 256 * j;
            const f32x4 gg = *(const f32x4*)(g + k), sc1 = *(const f32x4*)(scl + k), sh0 = *(const f32x4*)(sh + k);
            const f32x4 gs = gg * (sc1 + 1.f);
#pragma unroll
            for (int q = 0; q < NR; ++q) { const f32x4 o = v[q][j] * rstd[q] * gs + sh0;
                u32x2 w; w.x = pk2(o.x, o.y); w.y = pk2(o.z, o.w); *(u32x2*)(H + (size_t)(r + q) * DM + k) = w; } }
    }
}

__device__ __forceinline__ void final_norm(const Ctx& F) {
    const float* g = F.in[19];
    constexpr int NR = 4;
    const int gw = F.bid * NWAVES + F.wave, NGW = F.G * NWAVES;
    for (int r = NR * gw; r < ML; r += NR * NGW) {
        float* xr = F.out + (size_t)r * DM;
        f32x4 v[NR][4];
#pragma unroll
        for (int q = 0; q < NR; ++q)
#pragma unroll
            for (int j = 0; j < 4; ++j) v[q][j] = *(const f32x4*)(xr + q * DM + 4 * F.lane + 256 * j);
        float rstd[NR];
#pragma unroll
        for (int q = 0; q < NR; ++q) { float s = 0.f;
#pragma unroll
            for (int j = 0; j < 4; ++j) s += (v[q][j].x * v[q][j].x + v[q][j].y * v[q][j].y) + (v[q][j].z * v[q][j].z + v[q][j].w * v[q][j].w);
            rstd[q] = 1.f / sqrtf(wave_sum(s) * (1.f / DM) + EPS); }
#pragma unroll
        for (int j = 0; j < 4; ++j) { const int k = 4 * F.lane + 256 * j; const f32x4 gg = *(const f32x4*)(g + k);
#pragma unroll
            for (int q = 0; q < NR; ++q) *(f32x4*)(xr + q * DM + k) = v[q][j] * rstd[q] * gg; }
    }
}
#define XB_TMO      128
#define XB_XCNT(j)  (256  + 64 * (j))
#define XB_XSUB(j)  (1280 + 64 * (j))
#define XB_XGEN(j)  (2304 + 64 * (j))
#define XB_TOP      3328
#define XB_TOPGEN   3392
#define XCD_BAR_WORDS 3456
#define XB_SPIN_CAP (1u << 18)

__device__ __forceinline__ unsigned xb_ld(unsigned* p)              { return __hip_atomic_load(p, __ATOMIC_RELAXED, __HIP_MEMORY_SCOPE_AGENT); }
__device__ __forceinline__ unsigned xb_add(unsigned* p, unsigned v) { return __hip_atomic_fetch_add(p, v, __ATOMIC_RELAXED, __HIP_MEMORY_SCOPE_AGENT); }
__device__ __forceinline__ unsigned xb_xcc_id() { return (unsigned)__builtin_amdgcn_s_getreg((3 << 11) | 20) & 0xFu; }
#define XB_SPIN(cond, bar) do { unsigned _sp = 0; while (cond) { __builtin_amdgcn_s_sleep(1); \
    if ((++_sp & 255u) == 0u) { if (xb_ld(&(bar)[XB_TMO])) break; if (_sp > XB_SPIN_CAP) { atomicAdd(&(bar)[XB_TMO], 1u); break; } } } } while (0)

struct XcdBarrier {
    unsigned* bar; unsigned x;
    volatile LAS unsigned* st;
};

__device__ __forceinline__ XcdBarrier xcd_barrier_post(unsigned* bar, volatile LAS unsigned* st) {
    XcdBarrier b; b.bar = bar; b.x = xb_xcc_id(); b.st = st;
    if (threadIdx.x == 0) (void)xb_add(&bar[XB_XCNT(b.x)], 1u);
    return b;
}
__device__ __forceinline__ void xcd_barrier_complete(unsigned* bar, unsigned x, unsigned& nloc, unsigned& nx) {
    const unsigned G = gridDim.x * gridDim.y * gridDim.z;
    unsigned sum, cnt, mine, sp = 0u;
    for (;;) {
        sum = 0u; cnt = 0u; mine = 0u;
#pragma unroll
        for (unsigned j = 0; j < 16; ++j) { const unsigned c = xb_ld(&bar[XB_XCNT(j)]); sum += c; cnt += (c > 0u) ? 1u : 0u; mine = (j == x) ? c : mine; }
        if (sum == G) break;
        __builtin_amdgcn_s_sleep(1);
        if ((++sp & 255u) == 0u) { if (xb_ld(&bar[XB_TMO])) break; if (sp > XB_SPIN_CAP) { atomicAdd(&bar[XB_TMO], 1u); break; } }
    }
    nloc = mine > 0u ? mine : 1u; nx = cnt > 0u ? cnt : 1u;
}

__device__ __forceinline__ void xcd_barrier(const XcdBarrier& b) {
    asm volatile("s_waitcnt vmcnt(0)" ::: "memory");
    __syncthreads();
    if (threadIdx.x == 0) {
        unsigned* bar = b.bar;
        __builtin_amdgcn_s_waitcnt(0);
        unsigned nloc = b.st[0], nx = b.st[1];
        if (nloc == 0u) { xcd_barrier_complete(bar, b.x, nloc, nx); b.st[0] = nloc; b.st[1] = nx; }
        const unsigned old = xb_add(&bar[XB_XSUB(b.x)], 1u);
        const unsigned gen = old / nloc;
        if (old + 1u == (gen + 1u) * nloc) {
            __builtin_amdgcn_fence(__ATOMIC_RELEASE, "agent");
            asm volatile("s_waitcnt vmcnt(0)" ::: "memory");
            const unsigned og = xb_add(&bar[XB_TOP], 1u);
            const unsigned tg = og / nx;
            if (og + 1u == (tg + 1u) * nx) xb_add(&bar[XB_TOPGEN], 1u);
            else XB_SPIN(xb_ld(&bar[XB_TOPGEN]) == tg, bar);
            __builtin_amdgcn_fence(__ATOMIC_ACQUIRE, "agent");
            xb_add(&bar[XB_XGEN(b.x)], 1u);
            asm volatile("s_waitcnt vmcnt(0)" ::: "memory");
        } else {
            XB_SPIN(xb_ld(&bar[XB_XGEN(b.x)]) == gen, bar);
            __builtin_amdgcn_fence(__ATOMIC_ACQUIRE, "agent");
            asm volatile("s_waitcnt vmcnt(0)" ::: "memory");
        }
    }
    __syncthreads();
}
constexpr int NATT_LAT = NBATCH * 2 * 32, NATT_CTX = NBATCH * 2 * 2;
__device__ __forceinline__ void attn_task(const Ctx& F, int t, const bf16* P, bf16* MIX, const float* sink) {
    int tid_ = F.tid; asm volatile("" : "+v"(tid_)); const int tid = tid_, wave = __builtin_amdgcn_readfirstlane(tid_ >> 6), lane = tid_ & 63, quad = lane >> 4, l15 = lane & 15;
    bool lat; int b, g, qb;
    if (t < NATT_LAT) { lat = true; b = t >> 6; g = (t >> 5) & 1; qb = t & 31; } else { lat = false; const int u = t - NATT_LAT; b = u >> 2; g = (u >> 1) & 1; qb = u & 1; }
    const int qrow0 = (lat ? b * SEQ : ML + b * CTXL) + qb * 128 + (wave & 1) * 64;
    const int hq = g * 4 + (wave >> 1);
    LAS bf16* Ks = (LAS bf16*)F.lds; LAS bf16* VsT = (LAS bf16*)(F.lds + TB);
    bf16x8 qf[4][2];
#pragma unroll
    for (int nb = 0; nb < 4; ++nb)
#pragma unroll
        for (int ks = 0; ks < 2; ++ks) qf[nb][ks] = *(const bf16x8*)(P + (size_t)(qrow0 + nb * 16 + l15) * NP + hq * 64 + ks * 32 + 8 * quad);
    const float sk = sink[hq] * 1.4426950408889634f;
    float m_[4], l_[4];
#pragma unroll
    for (int nb = 0; nb < 4; ++nb) { m_[nb] = sk; l_[nb] = (quad == 0) ? 1.f : 0.f; }
    f32x4 ot[4][4];
#pragma unroll
    for (int d = 0; d < 4; ++d)
#pragma unroll
        for (int nb = 0; nb < 4; ++nb) ot[d][nb] = (f32x4){0.f, 0.f, 0.f, 0.f};
    const int t0 = lat ? (2 * qb - 2 < 0 ? 0 : 2 * qb - 2) : 0, t1 = lat ? (2 * qb + 3 > 63 ? 63 : 2 * qb + 3) : -1;
    const int nl = t1 - t0 + 1;
    const int sr = tid >> 3, sc8 = tid & 7;
    bf16x8 kv, vv;
    { const int krow0 = nl > 0 ? b * SEQ + t0 * 64 : ML + b * CTXL;
      kv = *(const bf16x8*)(P + (size_t)(krow0 + sr) * NP + 512 + g * 64 + sc8 * 8); vv = *(const bf16x8*)(P + (size_t)(krow0 + sr) * NP + 640 + g * 64 + sc8 * 8); }
    const int vpos = 32 * (sr >> 5) + 8 * ((sr >> 2) & 3) + 4 * ((sr >> 4) & 1) + (sr & 3);
    for (int it = 0; it < nl + 4; ++it) {
        const bool isloc = it < nl;
        LBAR();
        *(LAS bf16x8*)(Ks + sr * LT + sc8 * 8) = kv;
#pragma unroll
        for (int j = 0; j < 8; ++j) VsT[(sc8 * 8 + j) * LT + vpos] = (bf16)vv[j];
        if (it + 1 < nl + 4) { const int krow1 = (it + 1 < nl) ? b * SEQ + (t0 + it + 1) * 64 : ML + b * CTXL + (it + 1 - nl) * 64;
            kv = *(const bf16x8*)(P + (size_t)(krow1 + sr) * NP + 512 + g * 64 + sc8 * 8); vv = *(const bf16x8*)(P + (size_t)(krow1 + sr) * NP + 640 + g * 64 + sc8 * 8); }
        LBAR();
        const int kt0 = (t0 + it) * 64, q0w = qb * 128 + (wave & 1) * 64;
        if (isloc && (kt0 >= q0w + 192 || kt0 <= q0w - 192)) continue;
        const bool needmask = isloc && (kt0 > q0w + 65 || kt0 < q0w - 65);
        f32x4 st[4][4];
#pragma unroll
        for (int mb = 0; mb < 4; ++mb)
#pragma unroll
            for (int nb = 0; nb < 4; ++nb) { const float nm = -m_[nb]; st[mb][nb] = (f32x4){nm, nm, nm, nm}; }
        {
            bf16x8 kfr[4][2];
#pragma unroll
            for (int mb = 0; mb < 4; ++mb)
#pragma unroll
                for (int ks = 0; ks < 2; ++ks) kfr[mb][ks] = *(const LAS bf16x8*)(Ks + (mb * 16 + l15) * LT + ks * 32 + 8 * quad);
#pragma unroll
            for (int mb = 0; mb < 4; ++mb)
#pragma unroll
                for (int ks = 0; ks < 2; ++ks)
#pragma unroll
                    for (int nb = 0; nb < 4; ++nb) st[mb][nb] = MFMA16(kfr[mb][ks], qf[nb][ks], st[mb][nb]);
        }

        if (needmask) { const int kbase = (t0 + it) * 64 + 4 * quad;
#pragma unroll
            for (int nb = 0; nb < 4; ++nb) { const int qpos = qb * 128 + (wave & 1) * 64 + nb * 16 + l15;
#pragma unroll
                for (int mb = 0; mb < 4; ++mb)
#pragma unroll
                    for (int i = 0; i < 4; ++i) { const int d = qpos - (kbase + mb * 16 + i); if (d > 128 || d < -128) st[mb][nb][i] = -INFINITY; } } }
        float mx[4];
#pragma unroll
        for (int nb = 0; nb < 4; ++nb) { float v = -INFINITY;
#pragma unroll
            for (int mb = 0; mb < 4; ++mb) v = fmaxf(v, fmaxf(fmaxf(st[mb][nb][0], st[mb][nb][1]), fmaxf(st[mb][nb][2], st[mb][nb][3])));
            v = fmaxf(v, __shfl_xor(v, 16)); mx[nb] = fmaxf(v, __shfl_xor(v, 32)); }
        if (__builtin_amdgcn_ballot_w64((mx[0] > 8.f) | (mx[1] > 8.f) | (mx[2] > 8.f) | (mx[3] > 8.f)) != 0ull) {
#pragma unroll
            for (int nb = 0; nb < 4; ++nb) { const float dm = fmaxf(mx[nb], 0.f), alpha = __builtin_amdgcn_exp2f(-dm);
                m_[nb] += dm; l_[nb] *= alpha;
#pragma unroll
                for (int d = 0; d < 4; ++d) ot[d][nb] = ot[d][nb] * alpha;
#pragma unroll
                for (int mb = 0; mb < 4; ++mb) st[mb][nb] = st[mb][nb] - dm; }
        }
#pragma unroll
        for (int nb = 0; nb < 4; ++nb) { float ls = 0.f;
#pragma unroll
            for (int mb = 0; mb < 4; ++mb)
#pragma unroll
                for (int i = 0; i < 4; ++i) { const float p = __builtin_amdgcn_exp2f(st[mb][nb][i]); ls += p; st[mb][nb][i] = p; }
            l_[nb] += ls; }
        bf16x8 vfr[4][2];
#pragma unroll
        for (int d = 0; d < 4; ++d)
#pragma unroll
            for (int kk = 0; kk < 2; ++kk) vfr[d][kk] = *(const LAS bf16x8*)(VsT + (d * 16 + l15) * LT + 32 * kk + 8 * quad);
#pragma unroll
        for (int kk = 0; kk < 2; ++kk) {
            bf16x8 pb[4];
#pragma unroll
            for (int nb = 0; nb < 4; ++nb) { u32x4 w; w.x = pk2(st[2 * kk][nb][0], st[2 * kk][nb][1]); w.y = pk2(st[2 * kk][nb][2], st[2 * kk][nb][3]);
                w.z = pk2(st[2 * kk + 1][nb][0], st[2 * kk + 1][nb][1]); w.w = pk2(st[2 * kk + 1][nb][2], st[2 * kk + 1][nb][3]); pb[nb] = __builtin_bit_cast(bf16x8, w); }
#pragma unroll
            for (int d = 0; d < 4; ++d) {
#pragma unroll
                for (int nb = 0; nb < 4; ++nb) ot[d][nb] = MFMA16(vfr[d][kk], pb[nb], ot[d][nb]);
            }
        }
    }
#pragma unroll
    for (int nb = 0; nb < 4; ++nb) {
        float lt = l_[nb]; lt += __shfl_xor(lt, 16); lt += __shfl_xor(lt, 32);
        const float inv = 1.f / lt;
        bf16* rowp = MIX + (size_t)(qrow0 + nb * 16 + l15) * DM + hq * 64 + 4 * quad;
#pragma unroll
        for (int d = 0; d < 4; ++d) { const f32x4 o = ot[d][nb] * inv; u32x2 w; w.x = pk2(o[0], o[1]); w.y = pk2(o[2], o[3]); *(u32x2*)(rowp + d * 16) = w; }
    }
}

template <int KS>
__device__ __forceinline__ void mmT(const LAS bf16* A, int lda, const LAS bf16* Bt, int ldb, int wave, int lane, f32x4 (&acc)[2]) {
    const int mb = wave >> 1, nb0 = (wave & 1) * 2, l15 = lane & 15, quad = lane >> 4;
#pragma unroll
    for (int ks = 0; ks < KS; ++ks) {
        const bf16x8 a = *(const LAS bf16x8*)(A + (mb * 16 + l15) * lda + ks * 32 + quad * 8);
#pragma unroll
        for (int j = 0; j < 2; ++j) { const bf16x8 bb = *(const LAS bf16x8*)(Bt + ((nb0 + j) * 16 + l15) * ldb + ks * 32 + quad * 8); acc[j] = MFMA16(a, bb, acc[j]); }
    }
}
__device__ __forceinline__ float pre_sum(float x, int lane) {
#pragma unroll
    for (int o = 1; o < 64; o <<= 1) { const float t = __shfl_up(x, o); if (lane >= o) x += t; }
    return x;
}
__device__ __forceinline__ float pre_max(float x, int lane) {
#pragma unroll
    for (int o = 1; o < 64; o <<= 1) { const float t = __shfl_up(x, o); if (lane >= o) x = fmaxf(x, t); }
    return x;
}
__device__ __forceinline__ float suf_max(float x, int lane) {
#pragma unroll
    for (int o = 1; o < 64; o <<= 1) { const float t = __shfl_down(x, o); if (lane + o < 64) x = fmaxf(x, t); }
    return x;
}
__device__ __forceinline__ int grp_row0(int b, int grp) { return grp < 16 ? b * SEQ + grp * 256 : ML + b * CTXL; }

template <int KS>
__device__ __forceinline__ void mmS(const LAS bf16* A, int lda, const LAS bf16* Bt, int ldb, int wave, int lane, f32x4 (&acc)[2]) {
    const int mb = wave >> 1, nb0 = (wave & 1) * 2, l15 = lane & 15, quad = lane >> 4;
#pragma unroll
    for (int ks = 0; ks < KS; ++ks) {
        const bf16x8 a = *(const LAS bf16x8*)(A + (mb * 16 + l15) * lda + ks * 32 + quad * 8);
#pragma unroll
        for (int j = 0; j < 2; ++j) { const bf16x8 bb = *(const LAS bf16x8*)(Bt + ((nb0 + j) * 16 + l15) * ldb + ks * 32 + quad * 8); acc[j] = MFMA16(bb, a, acc[j]); }
    }
}
__device__ __forceinline__ u32x2 pack4(const f32x4 v) { u32x2 w; w.x = pk2(v[0], v[1]); w.y = pk2(v[2], v[3]); return w; }
__device__ __forceinline__ void tr_tile(const LAS bf16* Nn, LAS bf16* T, LAS bf16* Tw, const LAS float* w, int wave, int lane) {
    const int mb = wave >> 1, nb0 = (wave & 1) * 2, l15 = lane & 15, quad = lane >> 4, ks = mb >> 1;
    const int hit = (mb & 1) * 16 + l15 - quad * 8;
    bf16x8 e;
#pragma unroll
    for (int q = 0; q < 8; ++q) e[q] = (q == hit) ? (short)0x3F80 : (short)0;
#pragma unroll
    for (int j = 0; j < 2; ++j) {
        const bf16x8 bb = *(const LAS bf16x8*)(Nn + ((nb0 + j) * 16 + l15) * LT + ks * 32 + quad * 8);
        f32x4 z = {0.f, 0.f, 0.f, 0.f};
        z = MFMA16(bb, e, z);
        const int o = (mb * 16 + l15) * LT + (nb0 + j) * 16 + 4 * quad;
        if (T) { float one = 1.f; asm volatile("" : "+v"(one));
            *(LAS u32x2*)(T + o) = pack4(z * one); }
        if (Tw) { const f32x4 wv = *(const LAS f32x4*)(w + (nb0 + j) * 16 + 4 * quad); *(LAS u32x2*)(Tw + o) = pack4(z * wv); }
    }
}
__device__ __forceinline__ unsigned pk2n(float lo, float hi) { unsigned r; asm volatile("v_cvt_pk_bf16_f32 %0, %1, %2\n\ts_nop 1" : "=v"(r) : "v"(lo), "v"(hi)); return r; }
__device__ __forceinline__ bf16x8 pack8n(const f32x4 a, const f32x4 b) { u32x4 w; w.x = pk2n(a[0], a[1]); w.y = pk2n(a[2], a[3]); w.z = pk2n(b[0], b[1]); w.w = pk2n(b[2], b[3]); return __builtin_bit_cast(bf16x8, w); }
__device__ __forceinline__ bf16x8 ident_frag(int blk, int l15, int quad) {
    const int hit = (blk & 1) * 16 + l15 - quad * 8; bf16x8 e;
#pragma unroll
    for (int q = 0; q < 8; ++q) e[q] = (q == hit) ? (short)0x3F80 : (short)0;
    return e;
}
__device__ __forceinline__ void mlstm_a_task(const Ctx& F, int t, const bf16* P, const float* SM) {
    int tid_ = F.tid; asm volatile("" : "+v"(tid_)); const int tid = tid_, wave = __builtin_amdgcn_readfirstlane(tid_ >> 6), lane = tid_ & 63, quad = lane >> 4, l15 = lane & 15;
    const int b = t / 68, h = (t / 17) & 3, grp = t % 17;
    const int row0 = grp_row0(b, grp);
    const int mb = wave >> 1, nb0 = (wave & 1) * 2;
    LAS bf16* Kn = (LAS bf16*)F.lds; LAS bf16* Vn = (LAS bf16*)(F.lds + 4 * TB);
    LAS float* w256 = (LAS float*)(F.lds + 8 * TB); LAS float* tots = w256 + 512; LAS float* mxs = tots + 8;
    float* MST = (float*)(F.ws + WS_MST); float* MSC = (float*)(F.ws + WS_MSC);
    const int r = tid >> 3, c = tid & 7;
    bf16x8 kreg[4], vreg[4];
#pragma unroll
    for (int j = 0; j < 4; ++j) { const bf16* rp = P + (size_t)(row0 + j * 64 + r) * NP + h * 64 + c * 8; kreg[j] = *(const bf16x8*)(rp + 1024); vreg[j] = *(const bf16x8*)(rp + 1280); }
    const int dir = wave >> 2, jw = wave & 3;
    const float* smr = SM + (size_t)(row0 + jw * 64 + lane) * NSM;
    const float iv = smr[dir * 4 + h], f = smr[8 + dir * 4 + h];
    const float pre = pre_sum(f, lane), tot = __shfl(pre, 63);
    const float bs = dir == 0 ? pre : tot - pre + f;
    LBAR();
    if (lane == 0) tots[dir * 4 + jw] = tot;
#pragma unroll
    for (int j = 0; j < 4; ++j) { *(LAS bf16x8*)(Kn + j * 64 * LT + r * LT + c * 8) = kreg[j]; *(LAS bf16x8*)(Vn + j * 64 * LT + r * LT + c * 8) = vreg[j]; }
    LBAR();
    float after = 0.f, aG = 0.f;
#pragma unroll
    for (int j = 0; j < 4; ++j) { const float tj = tots[dir * 4 + j]; aG += tj; if (dir == 0 ? (j > jw) : (j < jw)) after += tj; }
    const float gg = (tot - bs) + after + iv;
    const float mx = wave_max(gg);
    if (lane == 0) mxs[dir * 4 + jw] = mx;
    LBAR();
    const float mG = fmaxf(fmaxf(mxs[dir * 4], mxs[dir * 4 + 1]), fmaxf(mxs[dir * 4 + 2], mxs[dir * 4 + 3]));
    w256[dir * 256 + jw * 64 + lane] = fexp(gg - mG);
    const int ch0 = (b * 4 + h) * 2;
    if (jw == 0 && lane == 0) { MSC[((size_t)(ch0 + dir) * NGRP + grp) * 2] = aG; MSC[((size_t)(ch0 + dir) * NGRP + grp) * 2 + 1] = mG; }
    LBAR();
    const bf16x8 ev = ident_frag(mb, l15, quad), ek0 = ident_frag(nb0, l15, quad), ek1 = ident_frag(nb0 + 1, l15, quad);
    const int ksv = mb >> 1, ksk = nb0 >> 1;
    f32x4 acc[2][2]; float nsum[2][2];
#pragma unroll
    for (int d2 = 0; d2 < 2; ++d2)
#pragma unroll
        for (int j2 = 0; j2 < 2; ++j2) { acc[d2][j2] = (f32x4){0.f, 0.f, 0.f, 0.f}; nsum[d2][j2] = 0.f; }
    const f32x4 zero4 = {0.f, 0.f, 0.f, 0.f};
    for (int j = 0; j < 4; ++j) {
        const LAS bf16* Kj = Kn + j * 64 * LT; const LAS bf16* Vj = Vn + j * 64 * LT;
#pragma unroll
        for (int hh = 0; hh < 2; ++hh) {
            const int sA = (2 * hh) * 16, sB = sA + 16;
            const f32x4 w0a = *(const LAS f32x4*)(w256 + j * 64 + sA + 4 * quad), w0b = *(const LAS f32x4*)(w256 + j * 64 + sB + 4 * quad);
            const f32x4 w1a = *(const LAS f32x4*)(w256 + 256 + j * 64 + sA + 4 * quad), w1b = *(const LAS f32x4*)(w256 + 256 + j * 64 + sB + 4 * quad);
            const f32x4 zva = MFMA16(*(const LAS bf16x8*)(Vj + (sA + l15) * LT + ksv * 32 + quad * 8), ev, zero4);
            const f32x4 zvb = MFMA16(*(const LAS bf16x8*)(Vj + (sB + l15) * LT + ksv * 32 + quad * 8), ev, zero4);
            const bf16x8 vf0 = pack8n(zva * w0a, zvb * w0b), vf1 = pack8n(zva * w1a, zvb * w1b);
#pragma unroll
            for (int j2 = 0; j2 < 2; ++j2) {
                const bf16x8 ek = j2 == 0 ? ek0 : ek1;
                const f32x4 zka = MFMA16(*(const LAS bf16x8*)(Kj + (sA + l15) * LT + ksk * 32 + quad * 8), ek, zero4);
                const f32x4 zkb = MFMA16(*(const LAS bf16x8*)(Kj + (sB + l15) * LT + ksk * 32 + quad * 8), ek, zero4);
                const f32x4 pa0 = zka * w0a, pb0 = zkb * w0b, pa1 = zka * w1a, pb1 = zkb * w1b;
                nsum[0][j2] += ((pa0[0] + pa0[1]) + (pa0[2] + pa0[3])) + ((pb0[0] + pb0[1]) + (pb0[2] + pb0[3]));
                nsum[1][j2] += ((pa1[0] + pa1[1]) + (pa1[2] + pa1[3])) + ((pb1[0] + pb1[1]) + (pb1[2] + pb1[3]));
                float one = 1.f; asm volatile("" : "+v"(one));
                const bf16x8 kf = pack8n(zka * one, zkb * one);
                acc[0][j2] = MFMA16(kf, vf0, acc[0][j2]);
                acc[1][j2] = MFMA16(kf, vf1, acc[1][j2]);
            }
        }
    }
#pragma unroll
    for (int d2 = 0; d2 < 2; ++d2) {
        float* dst = MST + ((size_t)(ch0 + d2) * NGRP + grp) * MST_TILE;
#pragma unroll
        for (int j2 = 0; j2 < 2; ++j2) {
            *(f32x4*)(dst + (mb * 16 + l15) * 64 + (nb0 + j2) * 16 + 4 * quad) = acc[d2][j2];
            float n = nsum[d2][j2]; n += __shfl_xor(n, 16); n += __shfl_xor(n, 32);
            if (mb == 0 && quad == 0) dst[4096 + (nb0 + j2) * 16 + l15] = n;
        }
    }
}

__device__ __forceinline__ void mlstm_c_task(const Ctx& F, int t, const bf16* P, const float* SM, bf16* MIX, const float* gn) {
    int tid_ = F.tid; asm volatile("" : "+v"(tid_)); const int tid = tid_, wave = __builtin_amdgcn_readfirstlane(tid_ >> 6), lane = tid_ & 63, quad = lane >> 4, l15 = lane & 15;
    const int b = t / 68, h = (t / 17) & 3, grp = t % 17;
    const int row0 = grp_row0(b, grp);
    const int mb = wave >> 1, nb0 = (wave & 1) * 2;
    const int rr = mb * 16 + l15;
    LAS bf16* Qn = (LAS bf16*)F.lds; LAS bf16* Kn = (LAS bf16*)(F.lds + TB); LAS bf16* Vn = (LAS bf16*)(F.lds + 2 * TB); LAS bf16* KT = (LAS bf16*)(F.lds + 3 * TB);
    LAS bf16* VT = (LAS bf16*)(F.lds + 4 * TB); LAS bf16* VTw = (LAS bf16*)(F.lds + 5 * TB); LAS bf16* Pd = (LAS bf16*)(F.lds + 6 * TB); LAS bf16* Cst = (LAS bf16*)(F.lds + 7 * TB);
    LAS bf16* stash = (LAS bf16*)(F.lds + 8 * TB);
    LAS float* fs = (LAS float*)(F.lds + 8 * TB + 32768);
    LAS float* nvec = fs, *psum = fs + 64, *nq_s = fs + 192, *ssq = fs + 256, *scalA = fs + 384, *GG = fs + 400;
    const float* MST = (const float*)(F.ws + WS_MST); const float* MPREV = (const float*)(F.ws + WS_MSC) + 512 * NGRP * 2;
    const int r = tid >> 3, c = tid & 7;
    const size_t base0 = (size_t)((b * 4 + h) * 2) * NGRP + grp, base1 = base0 + NGRP;
    const bool zst = grp == 16;
    f32x4 accC[2];
#pragma unroll
    for (int j = 0; j < 2; ++j) accC[j] = zst ? (f32x4){0.f, 0.f, 0.f, 0.f} : *(const f32x4*)(MST + base1 * MST_TILE + rr * 64 + (nb0 + j) * 16 + 4 * quad);
    float m = zst ? 0.f : MPREV[base1]; const float m0 = zst ? 0.f : MPREV[base0];
    float nv1 = 0.f, nv0 = 0.f; if (tid < 64 && !zst) { nv1 = MST[base1 * MST_TILE + 4096 + tid]; nv0 = MST[base0 * MST_TILE + 4096 + tid]; }
    const f32x4 gn0 = *(const f32x4*)(gn + h * 64 + nb0 * 16 + 4 * quad), gn1 = *(const f32x4*)(gn + h * 64 + (nb0 + 1) * 16 + 4 * quad);
#define MC_JC(idx) (((idx) < 4) ? (3 - ((idx) & 3)) : ((idx) & 3))
    bf16x8 pq, pk, pv_;
    { const int rows = row0 + MC_JC(0) * 64; const bf16* rp = P + (size_t)(rows + r) * NP + h * 64 + c * 8;
      pq = *(const bf16x8*)(rp + 768); pk = *(const bf16x8*)(rp + 1024); pv_ = *(const bf16x8*)(rp + 1280); }
    LBAR();
    {
        const int gdir = wave < 4 ? 1 : 0; const int grows = row0 + MC_JC(wave) * 64;
        const float* smr = SM + (size_t)(grows + lane) * NSM;
        const float iv = smr[gdir * 4 + h], f = smr[8 + gdir * 4 + h];
        const float pre = pre_sum(f, lane), tot = __shfl(pre, 63);
        const float bs = gdir == 0 ? pre : tot - pre + f;
        const float uu = iv - bs;
        const float cmv = gdir == 0 ? pre_max(uu, lane) : suf_max(uu, lane);
        const float gg = tot - bs + iv;
        const float mch = wave_max(gg);
        LAS float* g = GG + wave * 256;
        g[lane] = bs; g[64 + lane] = uu; g[128 + lane] = cmv; g[192 + lane] = fexp(gg - mch);
        if (lane == 0) { scalA[wave * 2] = tot; scalA[wave * 2 + 1] = mch; }
    }
    for (int idx = 0; idx < 8; ++idx) {
        const int dir = idx < 4 ? 1 : 0, step = idx & 3, jc = MC_JC(idx);
        const int rows = row0 + jc * 64;
        if (idx == 4) { m = m0;
#pragma unroll
            for (int j = 0; j < 2; ++j) accC[j] = zst ? (f32x4){0.f, 0.f, 0.f, 0.f} : *(const f32x4*)(MST + base0 * MST_TILE + rr * 64 + (nb0 + j) * 16 + 4 * quad); }
        LBAR();
        if (step == 0) {
            if (tid < 64) nvec[tid] = dir == 1 ? nv1 : nv0;
#pragma unroll
            for (int j = 0; j < 2; ++j) *(LAS u32x2*)(Cst + rr * LT + (nb0 + j) * 16 + 4 * quad) = pack4(accC[j]);
        }
        *(LAS bf16x8*)(Qn + r * LT + c * 8) = pq; *(LAS bf16x8*)(Kn + r * LT + c * 8) = pk; *(LAS bf16x8*)(Vn + r * LT + c * 8) = pv_;
        const LAS float* bs_s = GG + idx * 256, *u_s = bs_s + 64, *cm_s = bs_s + 128, *w_s = bs_s + 192; const LAS float* scal = scalA + idx * 2;
        if (idx + 1 < 8) { const int nrows = row0 + MC_JC(idx + 1) * 64; const bf16* rp = P + (size_t)(nrows + r) * NP + h * 64 + c * 8;
            pq = *(const bf16x8*)(rp + 768); pk = *(const bf16x8*)(rp + 1024); pv_ = *(const bf16x8*)(rp + 1280); }
        u32x2 gate[2] = {{0u, 0u}, {0u, 0u}};
        if (dir == 0) {
#pragma unroll
            for (int j = 0; j < 2; ++j) gate[j] = *(const u32x2*)(P + (size_t)(rows + rr) * NP + 1536 + h * 64 + (nb0 + j) * 16 + 4 * quad);
        }
        LBAR();
        tr_tile(Kn, KT, nullptr, nullptr, wave, lane);
        tr_tile(Vn, VT, VTw, w_s, wave, lane);
        const float mmr = fmaxf(m, cm_s[rr]);
        {
            f32x4 qk[2] = {{0.f, 0.f, 0.f, 0.f}, {0.f, 0.f, 0.f, 0.f}};
            mmS<2>(Qn, LT, Kn, LT, wave, lane, qk);
            float ps = 0.f;
#pragma unroll
            for (int j = 0; j < 2; ++j) { const int s0 = (nb0 + j) * 16 + 4 * quad; const f32x4 u4 = *(const LAS f32x4*)(u_s + s0); f32x4 p;
#pragma unroll
                for (int i = 0; i < 4; ++i) { const int ss = s0 + i; const bool ok = dir == 0 ? (ss <= rr) : (ss >= rr); p[i] = ok ? fexp(u4[i] - mmr) * qk[j][i] : 0.f; }
                const u32x2 pw = pack4(p); *(LAS u32x2*)(Pd + rr * LT + s0) = pw;
                ps += __builtin_bit_cast(float, pw.x << 16) + __builtin_bit_cast(float, pw.x & 0xffff0000u) + __builtin_bit_cast(float, pw.y << 16) + __builtin_bit_cast(float, pw.y & 0xffff0000u); }
            ps += __shfl_xor(ps, 16); ps += __shfl_xor(ps, 32);
            if (quad == 0) psum[(wave & 1) * 64 + rr] = ps;
        }
        if (tid >= 256) { const int r2 = (tid - 256) >> 2, part = tid & 3; float a = 0.f;
            const bf16x8 q0 = *(const LAS bf16x8*)(Qn + r2 * LT + part * 16), q1 = *(const LAS bf16x8*)(Qn + r2 * LT + part * 16 + 8);
#pragma unroll
            for (int e = 0; e < 8; ++e) a += nvec[part * 16 + e] * bfs2f(q0[e]) + nvec[part * 16 + 8 + e] * bfs2f(q1[e]);
            a += __shfl_xor(a, 1); a += __shfl_xor(a, 2);
            if (part == 0) nq_s[r2] = a; }
        LBAR();
        f32x4 hv[2];
        {
            f32x4 cq[2] = {{0.f, 0.f, 0.f, 0.f}, {0.f, 0.f, 0.f, 0.f}}, pv[2] = {{0.f, 0.f, 0.f, 0.f}, {0.f, 0.f, 0.f, 0.f}};
            mmS<2>(Qn, LT, Cst, LT, wave, lane, cq);
            mmS<2>(Pd, LT, VT, LT, wave, lane, pv);
            const float wi = fexp(m - mmr);
            const float den = wi * nq_s[rr] + psum[rr] + psum[64 + rr];
            const float hd = fmaxf(fabsf(den), fexp(-(bs_s[rr] + mmr))); const float inv = 1.f / hd;
            hv[0] = (cq[0] * wi + pv[0]) * inv; hv[1] = (cq[1] * wi + pv[1]) * inv;
        }
        LAS u32x2* sp = (LAS u32x2*)stash + ((jc * 8 + wave) * 2) * 64 + lane;
        if (dir == 1) { sp[0] = pack4(hv[0]); sp[64] = pack4(hv[1]); }
        else {
            float sq = 0.f;
#pragma unroll
            for (int j = 0; j < 2; ++j) { const u32x2 sv = sp[j * 64];
                hv[j][0] += __builtin_bit_cast(float, sv.x << 16); hv[j][1] += __builtin_bit_cast(float, sv.x & 0xffff0000u); hv[j][2] += __builtin_bit_cast(float, sv.y << 16); hv[j][3] += __builtin_bit_cast(float, sv.y & 0xffff0000u);
                sq += hv[j][0] * hv[j][0] + hv[j][1] * hv[j][1] + hv[j][2] * hv[j][2] + hv[j][3] * hv[j][3]; }
            sq += __shfl_xor(sq, 16); sq += __shfl_xor(sq, 32);
            if (quad == 0) ssq[(wave & 1) * 64 + rr] = sq;
            LBAR();
            const float rs = 1.f / sqrtf((ssq[rr] + ssq[64 + rr]) * (1.f / 64.f) + EPS);
#pragma unroll
            for (int j = 0; j < 2; ++j) { const f32x4 gnv = j == 0 ? gn0 : gn1; const u32x2 gt = gate[j];
                f32x4 o; o[0] = hv[j][0] * rs * gnv[0] * __builtin_bit_cast(float, gt.x << 16); o[1] = hv[j][1] * rs * gnv[1] * __builtin_bit_cast(float, gt.x & 0xffff0000u);
                o[2] = hv[j][2] * rs * gnv[2] * __builtin_bit_cast(float, gt.y << 16); o[3] = hv[j][3] * rs * gnv[3] * __builtin_bit_cast(float, gt.y & 0xffff0000u);
                *(u32x2*)(MIX + (size_t)(rows + rr) * DM + 512 + h * 64 + (nb0 + j) * 16 + 4 * quad) = pack4(o); }
        }
        if (step < 3) {
            const float a = scal[0], mch = scal[1];
            const float mnew = fmaxf(a + m, mch), so = fexp(a + m - mnew), sn = fexp(mch - mnew);
            f32x4 cc[2] = {{0.f, 0.f, 0.f, 0.f}, {0.f, 0.f, 0.f, 0.f}};
            mmS<2>(VTw, LT, KT, LT, wave, lane, cc);
            accC[0] = accC[0] * so + cc[0] * sn; accC[1] = accC[1] * so + cc[1] * sn;
            m = mnew;
            LBAR();
            if (tid < 256) { const int e = tid >> 2, part = tid & 3; float nn = 0.f;
                const bf16x8 k0 = *(const LAS bf16x8*)(KT + e * LT + part * 16), k1 = *(const LAS bf16x8*)(KT + e * LT + part * 16 + 8);
#pragma unroll
                for (int q = 0; q < 8; ++q) nn += w_s[part * 16 + q] * bfs2f(k0[q]) + w_s[part * 16 + 8 + q] * bfs2f(k1[q]);
                nn += __shfl_xor(nn, 1); nn += __shfl_xor(nn, 2);
                if (part == 0) nvec[e] = so * nvec[e] + sn * nn; }
#pragma unroll
            for (int j = 0; j < 2; ++j) *(LAS u32x2*)(Cst + rr * LT + (nb0 + j) * 16 + 4 * quad) = pack4(accC[j]);
        }
    }
#undef MC_JC
}

__device__ __forceinline__ float gla_glog(const LAS float* gr, const float (&wa)[16], float ba) {
    float z = ba;
#pragma unroll
    for (int q = 0; q < 4; ++q) { const f32x4 g4 = *(const LAS f32x4*)(gr + 4 * q); z += g4[0] * wa[4 * q] + g4[1] * wa[4 * q + 1] + g4[2] * wa[4 * q + 2] + g4[3] * wa[4 * q + 3]; }
    return logsigmoid_fast(z) * (1.f / 16.f);
}
__device__ __forceinline__ void gla_a_task(const Ctx& F, int t, const bf16* P, const float* SM, const float* wa2, const float* gba) {
    int tid_ = F.tid; asm volatile("" : "+v"(tid_)); const int tid = tid_, wave = __builtin_amdgcn_readfirstlane(tid_ >> 6), lane = tid_ & 63, quad = lane >> 4, l15 = lane & 15;
    const int b = t / 68, h = (t / 17) & 3, grp = t % 17;
    const int row0 = grp_row0(b, grp);
    const int mb = wave >> 1, nb0 = (wave & 1) * 2;
    LAS bf16* Vn = (LAS bf16*)F.lds; LAS bf16* KKn0 = (LAS bf16*)(F.lds + TB); LAS bf16* KKn1 = (LAS bf16*)(F.lds + 2 * TB);
    LAS float* gl = (LAS float*)(F.lds + 3 * TB);
    LAS float* glr_s = (LAS float*)(F.lds + 3 * TB + 32768);
    LAS float* tot_s = (LAS float*)(F.lds + 3 * TB + 32768 + 8192);
    LAS float* segtot = tot_s + 128;
    float* GST = (float*)(F.ws + WS_GST); float* GDEC = (float*)(F.ws + WS_GDEC);
    const int gd = tid & 63, gdir = (tid >> 6) & 1, sg = tid >> 7;
    float wa[16];
#pragma unroll
    for (int q = 0; q < 16; ++q) wa[q] = wa2[(size_t)(gdir * 16 + q) * 256 + h * 64 + gd];
    const float ba = gba[gdir * 256 + h * 64 + gd];
    f32x4 acc0[2] = {{0.f, 0.f, 0.f, 0.f}, {0.f, 0.f, 0.f, 0.f}}, acc1[2] = {{0.f, 0.f, 0.f, 0.f}, {0.f, 0.f, 0.f, 0.f}};
    f32x4 R0[2] = {{1.f, 1.f, 1.f, 1.f}, {1.f, 1.f, 1.f, 1.f}}, R1[2] = {{1.f, 1.f, 1.f, 1.f}, {1.f, 1.f, 1.f, 1.f}};
    const bf16x8 ev = ident_frag(mb, l15, quad), ek0 = ident_frag(nb0, l15, quad), ek1 = ident_frag(nb0 + 1, l15, quad);
    const int ksv = mb >> 1, ksk = nb0 >> 1;
    const f32x4 zero4 = {0.f, 0.f, 0.f, 0.f};
    const int r = tid >> 3, c = tid & 7;
    bf16x8 pk, pv_; f32x4 pg;
    { const int rows = row0 + 3 * 64; const bf16* rp = P + (size_t)(rows + r) * NP + h * 64 + c * 8; pk = *(const bf16x8*)(rp + 2048); pv_ = *(const bf16x8*)(rp + 2304);
      pg = *(const f32x4*)(SM + (size_t)(rows + r) * NSM + 16 + c * 4); }
    for (int jj = 0; jj < 4; ++jj) {
        LBAR();
        const bf16x8 kreg = pk;
        *(LAS bf16x8*)(Vn + r * LT + c * 8) = pv_;
        *(LAS f32x4*)(glr_s + r * 32 + c * 4) = pg;
        if (jj + 1 < 4) { const int nrows = row0 + (2 - jj) * 64; const bf16* rp = P + (size_t)(nrows + r) * NP + h * 64 + c * 8; pk = *(const bf16x8*)(rp + 2048); pv_ = *(const bf16x8*)(rp + 2304);
            pg = *(const f32x4*)(SM + (size_t)(nrows + r) * NSM + 16 + c * 4); }
        LBAR();
        {
            float gv[16];
#pragma unroll
            for (int i = 0; i < 16; ++i) gv[i] = gla_glog(glr_s + (sg * 16 + i) * 32 + gdir * 16, wa, ba);
            float run = 0.f;
            if (gdir == 0) {
#pragma unroll
                for (int i = 15; i >= 0; --i) { const float tv = gv[i]; gv[i] = run; run += tv; }
            } else {
#pragma unroll
                for (int i = 0; i < 16; ++i) { const float tv = gv[i]; gv[i] = run; run += tv; }
            }
            segtot[(gdir * 4 + sg) * 64 + gd] = run;
            LBAR();
            float off = 0.f, all = 0.f;
#pragma unroll
            for (int q = 0; q < 4; ++q) { const float tq = segtot[(gdir * 4 + q) * 64 + gd]; all += tq; if (gdir == 0 ? (q > sg) : (q < sg)) off += tq; }
#pragma unroll
            for (int i = 0; i < 16; ++i) gl[(gdir * 64 + sg * 16 + i) * 64 + gd] = gv[i] + off;
            if (sg == 0) tot_s[gdir * 64 + gd] = all;
        }
        LBAR();
        {
            const f32x4 a0 = *(const LAS f32x4*)(gl + r * 64 + c * 8), a1 = *(const LAS f32x4*)(gl + r * 64 + c * 8 + 4);
            const f32x4 b0 = *(const LAS f32x4*)(gl + (64 + r) * 64 + c * 8), b1 = *(const LAS f32x4*)(gl + (64 + r) * 64 + c * 8 + 4);
            float k0[8], k1[8];
#pragma unroll
            for (int i = 0; i < 8; ++i) { const float kv = bfs2f(kreg[i]); k0[i] = kv * fexp(i < 4 ? a0[i] : a1[i - 4]); k1[i] = kv * fexp(i < 4 ? b0[i] : b1[i - 4]); }
            u32x4 w;
            w.x = pk2(k0[0], k0[1]); w.y = pk2(k0[2], k0[3]); w.z = pk2(k0[4], k0[5]); w.w = pk2(k0[6], k0[7]); *(LAS u32x4*)(KKn0 + r * LT + c * 8) = w;
            w.x = pk2(k1[0], k1[1]); w.y = pk2(k1[2], k1[3]); w.z = pk2(k1[4], k1[5]); w.w = pk2(k1[6], k1[7]); *(LAS u32x4*)(KKn1 + r * LT + c * 8) = w;
        }
        LBAR();
        f32x4 t0[2] = {{0.f, 0.f, 0.f, 0.f}, {0.f, 0.f, 0.f, 0.f}}, t1[2] = {{0.f, 0.f, 0.f, 0.f}, {0.f, 0.f, 0.f, 0.f}};
        float one = 1.f; asm volatile("" : "+v"(one));
#pragma unroll
        for (int hh = 0; hh < 2; ++hh) {
            const int sA = (2 * hh) * 16, sB = sA + 16;
            const f32x4 zva = MFMA16(*(const LAS bf16x8*)(Vn + (sA + l15) * LT + ksv * 32 + quad * 8), ev, zero4);
            const f32x4 zvb = MFMA16(*(const LAS bf16x8*)(Vn + (sB + l15) * LT + ksv * 32 + quad * 8), ev, zero4);
            const bf16x8 vf = pack8n(zva * one, zvb * one);
#pragma unroll
            for (int j2 = 0; j2 < 2; ++j2) {
                const bf16x8 ek = j2 == 0 ? ek0 : ek1;
                const f32x4 za0 = MFMA16(*(const LAS bf16x8*)(KKn0 + (sA + l15) * LT + ksk * 32 + quad * 8), ek, zero4);
                const f32x4 zb0 = MFMA16(*(const LAS bf16x8*)(KKn0 + (sB + l15) * LT + ksk * 32 + quad * 8), ek, zero4);
                const f32x4 za1 = MFMA16(*(const LAS bf16x8*)(KKn1 + (sA + l15) * LT + ksk * 32 + quad * 8), ek, zero4);
                const f32x4 zb1 = MFMA16(*(const LAS bf16x8*)(KKn1 + (sB + l15) * LT + ksk * 32 + quad * 8), ek, zero4);
                const bf16x8 kf0 = pack8n(za0 * one, zb0 * one), kf1 = pack8n(za1 * one, zb1 * one);
                t0[j2] = MFMA16(kf0, vf, t0[j2]);
                t1[j2] = MFMA16(kf1, vf, t1[j2]);
            }
        }
#pragma unroll
        for (int j = 0; j < 2; ++j) { const f32x4 tt0 = *(const LAS f32x4*)(tot_s + (nb0 + j) * 16 + 4 * quad), tt1 = *(const LAS f32x4*)(tot_s + 64 + (nb0 + j) * 16 + 4 * quad);
            f32x4 e0, e1;
#pragma unroll
            for (int i = 0; i < 4; ++i) { e0[i] = fexp(tt0[i]); e1[i] = fexp(tt1[i]); }
            acc0[j] = acc0[j] + t0[j] * R0[j]; R0[j] = R0[j] * e0;
            acc1[j] = acc1[j] * e1 + t1[j]; R1[j] = R1[j] * e1; }
    }
    const size_t base0 = (size_t)((b * 4 + h) * 2) * NGRP + grp, base1 = base0 + NGRP;
#pragma unroll
    for (int j = 0; j < 2; ++j) { const int dk = (nb0 + j) * 16 + 4 * quad; const int dv = mb * 16 + l15;
        *(f32x4*)(GST + base0 * 4096 + dv * 64 + dk) = acc0[j]; *(f32x4*)(GST + base1 * 4096 + dv * 64 + dk) = acc1[j];
        if (mb == 0 && l15 == 0) { *(f32x4*)(GDEC + base0 * 64 + dk) = R0[j]; *(f32x4*)(GDEC + base1 * 64 + dk) = R1[j]; } }
}

__device__ __forceinline__ void gla_c_task(const Ctx& F, int t, const bf16* P, const float* SM, bf16* MIX, const float* wa2, const float* gba, const float* gn) {
    int tid_ = F.tid; asm volatile("" : "+v"(tid_)); const int tid = tid_, wave = __builtin_amdgcn_readfirstlane(tid_ >> 6), lane = tid_ & 63, quad = lane >> 4, l15 = lane & 15;
    const int b = t / 68, h = (t / 17) & 3, grp = t % 17;
    const int row0 = grp_row0(b, grp);
    const int mb = wave >> 1, nb0 = (wave & 1) * 2;
    const int rr = mb * 16 + l15;
    LAS bf16* Qd = (LAS bf16*)F.lds; LAS bf16* Kd = (LAS bf16*)(F.lds + TB); LAS bf16* KKn = (LAS bf16*)(F.lds + 2 * TB); LAS bf16* KKT = (LAS bf16*)(F.lds + 3 * TB);
    LAS bf16* Vn = (LAS bf16*)(F.lds + 4 * TB); LAS bf16* VT = (LAS bf16*)(F.lds + 5 * TB); LAS bf16* Att = (LAS bf16*)(F.lds + 6 * TB); LAS bf16* ST = (LAS bf16*)(F.lds + 7 * TB);
    LAS float* gl = (LAS float*)(F.lds + 8 * TB);
    LAS float* glr_s = (LAS float*)(F.lds + 8 * TB + 16384);
    LAS bf16* stash = (LAS bf16*)(F.lds + 8 * TB + 16384 + 4096);
    LAS float* ssq = (LAS float*)(F.lds + 8 * TB + 16384 + 4096 + 32768);
    LAS float* bend = ssq + 128;
    LAS float* segtot = bend + 64;
    const float* GST = (const float*)(F.ws + WS_GST);
    const int gd = tid & 63, sg = tid >> 6;
    const int r = tid >> 3, c = tid & 7;
    const size_t base0 = (size_t)((b * 4 + h) * 2) * NGRP + grp, base1 = base0 + NGRP;
    const bool zst = grp == 16;
    f32x4 accS[2];
#pragma unroll
    for (int j = 0; j < 2; ++j) accS[j] = zst ? (f32x4){0.f, 0.f, 0.f, 0.f} : *(const f32x4*)(GST + base1 * 4096 + rr * 64 + (nb0 + j) * 16 + 4 * quad);
    float wa[16];
#pragma unroll
    for (int q = 0; q < 16; ++q) wa[q] = wa2[(size_t)(16 + q) * 256 + h * 64 + gd];
    float ba = gba[256 + h * 64 + gd];
    const f32x4 gn0 = *(const f32x4*)(gn + h * 64 + nb0 * 16 + 4 * quad), gn1 = *(const f32x4*)(gn + h * 64 + (nb0 + 1) * 16 + 4 * quad);
#define GC_JC(idx) (((idx) < 4) ? (3 - ((idx) & 3)) : ((idx) & 3))
    bf16x8 pq, pk, pv_; f32x4 pg = {0.f, 0.f, 0.f, 0.f};
    { const int rows = row0 + GC_JC(0) * 64; const bf16* rp = P + (size_t)(rows + r) * NP + h * 64 + c * 8;
      pq = *(const bf16x8*)(rp + 1792); pk = *(const bf16x8*)(rp + 2048); pv_ = *(const bf16x8*)(rp + 2304);
      if (tid < 256) pg = *(const f32x4*)(SM + (size_t)(rows + (tid >> 2)) * NSM + 16 + 16 + (tid & 3) * 4); }
    for (int idx = 0; idx < 8; ++idx) {
        const int dir = idx < 4 ? 1 : 0, step = idx & 3, jc = GC_JC(idx);
        const int rows = row0 + jc * 64;
        if (idx == 4) {
#pragma unroll
            for (int j = 0; j < 2; ++j) accS[j] = zst ? (f32x4){0.f, 0.f, 0.f, 0.f} : *(const f32x4*)(GST + base0 * 4096 + rr * 64 + (nb0 + j) * 16 + 4 * quad);
#pragma unroll
            for (int q = 0; q < 16; ++q) wa[q] = wa2[(size_t)q * 256 + h * 64 + gd];
            ba = gba[h * 64 + gd]; }
        LBAR();
        if (step == 0) {
#pragma unroll
            for (int j = 0; j < 2; ++j) *(LAS u32x2*)(ST + rr * LT + (nb0 + j) * 16 + 4 * quad) = pack4(accS[j]);
        }
        const bf16x8 qreg = pq, kreg = pk;
        *(LAS bf16x8*)(Vn + r * LT + c * 8) = pv_;
        if (tid < 256) *(LAS f32x4*)(glr_s + (tid >> 2) * 16 + (tid & 3) * 4) = pg;
        if (idx + 1 < 8) { const int nd = (idx + 1) < 4 ? 1 : 0; const int nrows = row0 + GC_JC(idx + 1) * 64; const bf16* rp = P + (size_t)(nrows + r) * NP + h * 64 + c * 8;
            pq = *(const bf16x8*)(rp + 1792); pk = *(const bf16x8*)(rp + 2048); pv_ = *(const bf16x8*)(rp + 2304);
            if (tid < 256) pg = *(const f32x4*)(SM + (size_t)(nrows + (tid >> 2)) * NSM + 16 + nd * 16 + (tid & 3) * 4); }
        u32x2 gate[2] = {{0u, 0u}, {0u, 0u}};
        if (dir == 0) {
#pragma unroll
            for (int j = 0; j < 2; ++j) gate[j] = *(const u32x2*)(P + (size_t)(rows + rr) * NP + 2560 + h * 64 + (nb0 + j) * 16 + 4 * quad);
        }
        LBAR();
        {
            float gv[8];
#pragma unroll
            for (int i = 0; i < 8; ++i) gv[i] = gla_glog(glr_s + (sg * 8 + i) * 16, wa, ba);
            if (dir == 0) {
#pragma unroll
                for (int i = 1; i < 8; ++i) gv[i] += gv[i - 1];
                segtot[sg * 64 + gd] = gv[7];
            } else {
#pragma unroll
                for (int i = 6; i >= 0; --i) gv[i] += gv[i + 1];
                segtot[sg * 64 + gd] = gv[0];
            }
            tr_tile(Vn, VT, nullptr, nullptr, wave, lane);
            LBAR();
            float off = 0.f, all = 0.f;
#pragma unroll
            for (int q = 0; q < 8; ++q) { const float tq = segtot[q * 64 + gd]; all += tq; if (dir == 0 ? (q < sg) : (q > sg)) off += tq; }
#pragma unroll
            for (int i = 0; i < 8; ++i) gl[(sg * 8 + i) * 64 + gd] = gv[i] + off;
            if (sg == 0) bend[gd] = all;
        }
        LBAR();
        {
            const f32x4 b0 = *(const LAS f32x4*)(gl + r * 64 + c * 8), b1 = *(const LAS f32x4*)(gl + r * 64 + c * 8 + 4);
            const f32x4 e0 = *(const LAS f32x4*)(bend + c * 8), e1 = *(const LAS f32x4*)(bend + c * 8 + 4);
            float qd[8], kd[8], kk[8];
#pragma unroll
            for (int i = 0; i < 8; ++i) { const float bc = i < 4 ? b0[i] : b1[i - 4]; const float be = i < 4 ? e0[i] : e1[i - 4]; const float qv = bfs2f(qreg[i]), kv = bfs2f(kreg[i]);
                qd[i] = qv * fexp(bc); kd[i] = kv * fexp(-bc); kk[i] = kv * fexp(be - bc); }
            u32x4 w;
            w.x = pk2(qd[0], qd[1]); w.y = pk2(qd[2], qd[3]); w.z = pk2(qd[4], qd[5]); w.w = pk2(qd[6], qd[7]); *(LAS u32x4*)(Qd + r * LT + c * 8) = w;
            w.x = pk2(kd[0], kd[1]); w.y = pk2(kd[2], kd[3]); w.z = pk2(kd[4], kd[5]); w.w = pk2(kd[6], kd[7]); *(LAS u32x4*)(Kd + r * LT + c * 8) = w;
            w.x = pk2(kk[0], kk[1]); w.y = pk2(kk[2], kk[3]); w.z = pk2(kk[4], kk[5]); w.w = pk2(kk[6], kk[7]); *(LAS u32x4*)(KKn + r * LT + c * 8) = w;
        }
        LBAR();
        tr_tile(KKn, KKT, nullptr, nullptr, wave, lane);
        { f32x4 at[2] = {{0.f, 0.f, 0.f, 0.f}, {0.f, 0.f, 0.f, 0.f}};
          mmS<2>(Qd, LT, Kd, LT, wave, lane, at);
#pragma unroll
          for (int j = 0; j < 2; ++j) { const int s0 = (nb0 + j) * 16 + 4 * quad; f32x4 a4;
#pragma unroll
              for (int i = 0; i < 4; ++i) { const int ss = s0 + i; const bool ok = dir == 0 ? (ss <= rr) : (ss >= rr); a4[i] = ok ? at[j][i] : 0.f; }
              *(LAS u32x2*)(Att + rr * LT + s0) = pack4(a4); } }
        LBAR();
        f32x4 hv[2] = {{0.f, 0.f, 0.f, 0.f}, {0.f, 0.f, 0.f, 0.f}};
        mmS<2>(Att, LT, VT, LT, wave, lane, hv);
        mmS<2>(Qd, LT, ST, LT, wave, lane, hv);
        LAS u32x2* sp = (LAS u32x2*)stash + ((jc * 8 + wave) * 2) * 64 + lane;
        if (dir == 1) { float one = 1.f; asm volatile("" : "+v"(one)); sp[0] = pack4(hv[0] * one); sp[64] = pack4(hv[1] * one); }
        else {
            float sq = 0.f;
#pragma unroll
            for (int j = 0; j < 2; ++j) { const u32x2 sv = sp[j * 64];
                hv[j][0] += __builtin_bit_cast(float, sv.x << 16); hv[j][1] += __builtin_bit_cast(float, sv.x & 0xffff0000u); hv[j][2] += __builtin_bit_cast(float, sv.y << 16); hv[j][3] += __builtin_bit_cast(float, sv.y & 0xffff0000u);
                sq += hv[j][0] * hv[j][0] + hv[j][1] * hv[j][1] + hv[j][2] * hv[j][2] + hv[j][3] * hv[j][3]; }
            sq += __shfl_xor(sq, 16); sq += __shfl_xor(sq, 32);
            if (quad == 0) ssq[(wave & 1) * 64 + rr] = sq;
            LBAR();
            const float rs = 1.f / sqrtf((ssq[rr] + ssq[64 + rr]) * (1.f / 64.f) + EPS);
#pragma unroll
            for (int j = 0; j < 2; ++j) { const f32x4 gnv = j == 0 ? gn0 : gn1; const u32x2 gt = gate[j];
                f32x4 o; o[0] = hv[j][0] * rs * gnv[0] * __builtin_bit_cast(float, gt.x << 16); o[1] = hv[j][1] * rs * gnv[1] * __builtin_bit_cast(float, gt.x & 0xffff0000u);
                o[2] = hv[j][2] * rs * gnv[2] * __builtin_bit_cast(float, gt.y << 16); o[3] = hv[j][3] * rs * gnv[3] * __builtin_bit_cast(float, gt.y & 0xffff0000u);
                *(u32x2*)(MIX + (size_t)(rows + rr) * DM + 768 + h * 64 + (nb0 + j) * 16 + 4 * quad) = pack4(o); }
        }
        if (step < 3) {
            f32x4 ut[2] = {{0.f, 0.f, 0.f, 0.f}, {0.f, 0.f, 0.f, 0.f}};
            mmS<2>(VT, LT, KKT, LT, wave, lane, ut);
#pragma unroll
            for (int j = 0; j < 2; ++j) { const f32x4 be = *(const LAS f32x4*)(bend + (nb0 + j) * 16 + 4 * quad);
#pragma unroll
                for (int i = 0; i < 4; ++i) accS[j][i] = accS[j][i] * fexp(be[i]) + ut[j][i]; }
            LBAR();
#pragma unroll
            for (int j = 0; j < 2; ++j) *(LAS u32x2*)(ST + rr * LT + (nb0 + j) * 16 + 4 * quad) = pack4(accS[j]);
        }
    }
#undef GC_JC
}

__device__ __forceinline__ int scan_grp(int dir, int step) { return step == 0 ? 16 : (dir == 0 ? step - 1 : 16 - step); }
__device__ __forceinline__ void mlstm_scan_task(const Ctx& F, int pair) {
    int tid_ = F.tid; asm volatile("" : "+v"(tid_)); const int tid = tid_;
    f32x4* MST4 = (f32x4*)(F.ws + WS_MST); const float* MSC = (const float*)(F.ws + WS_MSC); float* MPREV = (float*)(F.ws + WS_MSC) + 512 * NGRP * 2;
    f32x4 st[2][3]; float m[2] = {0.f, 0.f};
    float zz = 0.f; asm volatile("" : "+v"(zz));
#pragma unroll
    for (int d = 0; d < 2; ++d)
#pragma unroll
        for (int q = 0; q < 3; ++q) st[d][q] = (f32x4){zz, zz, zz, zz};
    const bool has3 = tid < 16;
    f32x4 cur[2][3];
#pragma unroll
    for (int d = 0; d < 2; ++d) { const size_t base = (size_t)(pair * 2 + d) * NGRP + scan_grp(d, 0);
        cur[d][0] = MST4[base * 1040 + tid]; cur[d][1] = MST4[base * 1040 + 512 + tid]; cur[d][2] = has3 ? MST4[base * 1040 + 1024 + tid] : (f32x4){zz, zz, zz, zz}; }
    for (int step = 0; step < NGRP; ++step) {
        f32x4 nxt[2][3];
        if (step + 1 < NGRP) {
#pragma unroll
            for (int d = 0; d < 2; ++d) { const size_t nb = (size_t)(pair * 2 + d) * NGRP + scan_grp(d, step + 1);
                nxt[d][0] = MST4[nb * 1040 + tid]; nxt[d][1] = MST4[nb * 1040 + 512 + tid]; nxt[d][2] = has3 ? MST4[nb * 1040 + 1024 + tid] : (f32x4){zz, zz, zz, zz}; }
        }
#pragma unroll
        for (int d = 0; d < 2; ++d) { const size_t base = (size_t)(pair * 2 + d) * NGRP + scan_grp(d, step);
            const float a = MSC[base * 2], mi = MSC[base * 2 + 1];
            const float mnew = fmaxf(a + m[d], mi), so = fexp(a + m[d] - mnew), sn = fexp(mi - mnew);
            MST4[base * 1040 + tid] = st[d][0]; MST4[base * 1040 + 512 + tid] = st[d][1]; if (has3) MST4[base * 1040 + 1024 + tid] = st[d][2];
            if (tid == 0) MPREV[base] = m[d];
#pragma unroll
            for (int q = 0; q < 3; ++q) st[d][q] = st[d][q] * so + cur[d][q] * sn;
            m[d] = mnew; }
        if (step + 1 < NGRP) {
#pragma unroll
            for (int d = 0; d < 2; ++d)
#pragma unroll
                for (int q = 0; q < 3; ++q) cur[d][q] = nxt[d][q];
        }
    }
}
__device__ __forceinline__ void gla_scan_task(const Ctx& F, int pair) {
    int tid_ = F.tid; asm volatile("" : "+v"(tid_)); const int tid = tid_;
    f32x4* GST4 = (f32x4*)(F.ws + WS_GST); const f32x4* GDEC4 = (const f32x4*)(F.ws + WS_GDEC);
    f32x4 st[2][2], cur[2][2], dcur[2];
    float zz = 0.f; asm volatile("" : "+v"(zz));
#pragma unroll
    for (int d = 0; d < 2; ++d) { st[d][0] = (f32x4){zz, zz, zz, zz}; st[d][1] = (f32x4){zz, zz, zz, zz};
        const size_t base = (size_t)(pair * 2 + d) * NGRP + scan_grp(d, 0);
        cur[d][0] = GST4[base * 1024 + tid]; cur[d][1] = GST4[base * 1024 + 512 + tid]; dcur[d] = GDEC4[base * 16 + (tid & 15)]; }
    for (int step = 0; step < NGRP; ++step) {
        f32x4 nxt[2][2], dnxt[2];
        if (step + 1 < NGRP) {
#pragma unroll
            for (int d = 0; d < 2; ++d) { const size_t nb = (size_t)(pair * 2 + d) * NGRP + scan_grp(d, step + 1);
                nxt[d][0] = GST4[nb * 1024 + tid]; nxt[d][1] = GST4[nb * 1024 + 512 + tid]; dnxt[d] = GDEC4[nb * 16 + (tid & 15)]; }
        }
#pragma unroll
        for (int d = 0; d < 2; ++d) { const size_t base = (size_t)(pair * 2 + d) * NGRP + scan_grp(d, step);
            GST4[base * 1024 + tid] = st[d][0]; GST4[base * 1024 + 512 + tid] = st[d][1];
            st[d][0] = st[d][0] * dcur[d] + cur[d][0]; st[d][1] = st[d][1] * dcur[d] + cur[d][1]; }
        if (step + 1 < NGRP) {
#pragma unroll
            for (int d = 0; d < 2; ++d) { cur[d][0] = nxt[d][0]; cur[d][1] = nxt[d][1]; dcur[d] = dnxt[d]; }
        }
    }
}

__device__ __forceinline__ void mixer_phase_a(const Ctx& F, int l, bool last) {
    const bf16* P = (const bf16*)(F.ws + WS_P); bf16* MIX = (bf16*)(F.ws + WS_H); const float* SM = (const float*)(F.ws + WS_SM);
    const int nattn = last ? NATT_LAT : NATT_LAT + NATT_CTX;
    const int vb = (F.G & 7) == 0 ? (F.bid & 7) * (F.G >> 3) + (F.bid >> 3) : F.bid;
    for (int t = vb; t < nattn + 2 * 1088; t += F.G) {
        if (t < nattn) { attn_task(F, t, P, MIX, F.in[9] + l * 8);
#ifdef DUP_ATT
            attn_task(F, t, P, MIX, F.in[9] + l * 8);
#endif
        }
        else if (t < nattn + 1088) { mlstm_a_task(F, t - nattn, P, SM);
#ifdef DUP_MLA
            mlstm_a_task(F, t - nattn, P, SM);
#endif
        }
        else { gla_a_task(F, t - nattn - 1088, P, SM, F.in[13] + (size_t)l * 2 * 16 * 256, F.in[14] + (size_t)l * 2 * 256);
#ifdef DUP_GLA
            gla_a_task(F, t - nattn - 1088, P, SM, F.in[13] + (size_t)l * 2 * 16 * 256, F.in[14] + (size_t)l * 2 * 256);
#endif
        }
    }
}
__device__ __forceinline__ void mixer_phase_b(const Ctx& F, int l, bool last) {
    for (int t = F.bid; t < 128; t += F.G) { if (t < 64) mlstm_scan_task(F, t); else gla_scan_task(F, t - 64); }
    if (F.G >= 256 && !last) {
        const bf16* P = (const bf16*)(F.ws + WS_P); bf16* MIX = (bf16*)(F.ws + WS_H); const float* SM = (const float*)(F.ws + WS_SM);
        for (int u = F.bid - 128; u >= 0 && u < 128; u += F.G - 128) {
            if (u < 64) mlstm_c_task(F, u * 17 + 16, P, SM, MIX, F.in[12] + l * 256);
            else gla_c_task(F, (u - 64) * 17 + 16, P, SM, MIX, F.in[13] + (size_t)l * 2 * 16 * 256, F.in[14] + (size_t)l * 2 * 256, F.in[15] + l * 256);
        }
    }
}
__device__ __forceinline__ void mixer_phase_c(const Ctx& F, int l, bool last) {
    const bf16* P = (const bf16*)(F.ws + WS_P); bf16* MIX = (bf16*)(F.ws + WS_H); const float* SM = (const float*)(F.ws + WS_SM);
    if (F.G >= 256) {
        for (int t = F.bid; t < 2048; t += F.G) { const int idx = t & 1023, tt = (idx >> 4) * 17 + (idx & 15);
            if (t < 1024) mlstm_c_task(F, tt, P, SM, MIX, F.in[12] + l * 256);
            else gla_c_task(F, tt, P, SM, MIX, F.in[13] + (size_t)l * 2 * 16 * 256, F.in[14] + (size_t)l * 2 * 256, F.in[15] + l * 256); }
        return;
    }
    for (int t = F.bid; t < 2 * 1088; t += F.G) {
        const int tt = t < 1088 ? t : t - 1088;
        if (last && (tt % 17) == 16) continue;
        if (t < 1088) mlstm_c_task(F, tt, P, SM, MIX, F.in[12] + l * 256);
        else gla_c_task(F, tt, P, SM, MIX, F.in[13] + (size_t)l * 2 * 16 * 256, F.in[14] + (size_t)l * 2 * 256, F.in[15] + l * 256);
    }
}
__global__ void __launch_bounds__(NT, 2) fwd_mega(Args args) {
    extern __shared__ __attribute__((aligned(16))) unsigned char lds_raw[];
    cg::grid_group grid = cg::this_grid();
    Ctx F;
    F.lds = (LAS unsigned char*)lds_raw;
#define REFRESH() do { int t_ = threadIdx.x; asm volatile("" : "+v"(t_)); F.tid = t_; F.lane = t_ & 63; F.wave = __builtin_amdgcn_readfirstlane(t_ >> 6); } while (0)
    REFRESH();
    volatile LAS unsigned* bst = (volatile LAS unsigned*)(F.lds + 139264);
    if (F.tid < 4) bst[F.tid] = 0u;
    __syncthreads();
    (void)xcd_barrier_post((unsigned*)(args.ws + WS_BAR), bst);
#define GSYNC() do { XcdBarrier xb_; xb_.bar = (unsigned*)(args.ws + WS_BAR); xb_.x = xb_xcc_id(); xb_.st = (volatile LAS unsigned*)(F.lds + 139264); xcd_barrier(xb_); REFRESH(); } while (0)
    F.G = gridDim.x; F.bid = blockIdx.x; F.in = args.in; F.out = args.out; F.ws = args.ws;
    unsigned char* ws = args.ws;
    bf16* Hb = (bf16*)(ws + WS_H); bf16* Pb = (bf16*)(ws + WS_P); bf16* HID = (bf16*)(ws + WS_HID);
    float* SM = (float*)(ws + WS_SM); float* XC = (float*)(ws + WS_XC); const float* MOD = (const float*)(ws + WS_MOD);

#ifndef NO_PRO
    prologue(F);
#endif
    grid.sync(); REFRESH();

    for (int l = 0; l < DEPTH; ++l) {
        const bool last = (l == DEPTH - 1);
        const float* srcL = l == 0 ? args.in[0] : args.out; const float* srcC = l == 0 ? args.in[2] : XC;
        const float* modl = MOD + (size_t)l * 17 * 6144;
        const int Mpost = last ? ML : MT;
#ifndef NO_N
        norm_phase(F, srcL, srcC, args.in[6] + l * DM, modl, MT, (l > 0 && F.G == 256) ? (const float*)(ws + WS_PART) : nullptr, XC);
#ifdef DUP_N
        GSYNC(); norm_phase(F, srcL, srcC, args.in[6] + l * DM, modl, MT, nullptr, XC);
#endif
#endif
        GSYNC();
#ifndef NO_G1
        { LAS float* rl = (LAS float*)(F.lds + 131072); *(LAS f32x4*)(rl + F.tid * 4) = F.tid < 256 ? *(const f32x4*)(ROPE_C + F.tid * 4) : *(const f32x4*)(ROPE_S + (F.tid - 256) * 4); __syncthreads(); }
        { pg8::Gemm g{Hb, (const bf16*)(ws + WS_WIN) + (size_t)l * NINP * DM, MT, NINP, DM}; pg8::StaticOrder S; S.init(MT, NINP, F.G, F.bid);
          EpiIn E{Pb, SM, args.in[10] + l * 8, args.in[11] + l * 8, (const LAS float*)(F.lds + 131072)};
          pg8::gemm_phase<EpiIn, pg8::StaticOrder, true, true>(F.lds, g, S, E);
        }
#endif
        GSYNC();
#ifndef NO_MIX
        mixer_phase_a(F, l, last);
#ifdef DUP_MA
        GSYNC(); mixer_phase_a(F, l, last);
#endif
        GSYNC();
        mixer_phase_b(F, l, last);
        GSYNC();
        mixer_phase_c(F, l, last);
#ifdef DUP_MC
        GSYNC(); mixer_phase_c(F, l, last);
#endif
#endif
        GSYNC();
#ifndef NO_G2
        { pg8::Gemm g{Hb, (const bf16*)(ws + WS_WOUT) + (size_t)l * DM * DM, Mpost, DM, DM}; pg8::StaticOrder S; S.init(Mpost, DM, F.G, F.bid);
          EpiRes E{srcL, srcC, args.out, XC, modl + 2 * 1024, DM / 64, nullptr};
          pg8::gemm_phase<EpiRes, pg8::StaticOrder, true, true>(F.lds, g, S, E); }
#endif
        GSYNC();
#ifndef NO_N
        norm_phase(F, args.out, XC, args.in[7] + l * DM, modl + 3 * 1024, Mpost);
#ifdef DUP_N
        GSYNC(); norm_phase(F, args.out, XC, args.in[7] + l * DM, modl + 3 * 1024, Mpost);
#endif
#endif
        GSYNC();
#ifndef NO_G3
        { pg8::Gemm g{Hb, (const bf16*)(ws + WS_W1) + (size_t)l * FF * DM, Mpost, FF, DM}; pg8::StaticOrder S; S.init(Mpost, FF, F.G, F.bid);
          EpiRelu2 E{HID};
          pg8::gemm_phase<EpiRelu2, pg8::StaticOrder, true, true>(F.lds, g, S, E);
#ifdef DUP_G3
          GSYNC(); pg8::gemm_phase<EpiRelu2, pg8::StaticOrder, true, true>(F.lds, g, S, E);
#endif
        }
#endif
        GSYNC();
#ifndef NO_G4
        { pg8::Gemm g{HID, (const bf16*)(ws + WS_W2) + (size_t)l * DM * FF, Mpost, DM, FF};
          EpiRes E{args.out, XC, args.out, XC, modl + 5 * 1024, FF / 64, (float*)(ws + WS_PART)};
          if (last || F.G != 256) { pg8::StaticOrder S; S.init(Mpost, DM, F.G, F.bid, FF); pg8::gemm_phase<EpiRes, pg8::StaticOrder, true, true>(F.lds, g, S, E); }
          else { SplitOrder S; S.init(ML, DM, F.G, F.bid, FF); pg8::gemm_phase<EpiRes, SplitOrder, true, true>(F.lds, g, S, E); } }
#endif
        GSYNC();
    }
    final_norm(F);
}

extern "C" void kernel_launch(void* const* d_in, const int* in_sizes, int n_in, void* d_out, int out_size, void* d_ws, size_t ws_size, hipStream_t stream) {
    static int grid = 0;
    if (grid == 0) {
        if (n_in != 20 || out_size != ML * DM || ws_size < WS_END) { fprintf(stderr, "kernel_launch: unexpected shapes n_in %d out %d ws %zu\n", n_in, out_size, ws_size); grid = -1; return; }
        int dev = 0, cus = 0, per_cu = 0;
        (void)hipGetDevice(&dev); (void)hipDeviceGetAttribute(&cus, hipDeviceAttributeMultiprocessorCount, dev);
        if (hipFuncSetAttribute((const void*)fwd_mega, hipFuncAttributeMaxDynamicSharedMemorySize, LDS_BYTES) != hipSuccess) { fprintf(stderr, "kernel_launch: hipFuncSetAttribute failed\n"); grid = -1; return; }
        if (hipOccupancyMaxActiveBlocksPerMultiprocessor(&per_cu, (const void*)fwd_mega, NT, LDS_BYTES) != hipSuccess || per_cu < 1) { fprintf(stderr, "kernel_launch: occupancy query says %d\n", per_cu); per_cu = 1; }
        (void)hipGetLastError();
        grid = cus * 1;
        if (grid <= 0) grid = 256;
    }
    if (grid < 0) return;
    Args a{};
    for (int i = 0; i < 20; ++i) a.in[i] = (const float*)d_in[i];
    a.out = (float*)d_out; a.ws = (unsigned char*)d_ws;
    if (hipMemsetAsync((char*)d_ws + WS_BAR, 0, 16384, stream) != hipSuccess) { fprintf(stderr, "kernel_launch: memset of the barrier words failed\n"); return; }
    void* kargs[] = {&a};
    const hipError_t e = hipLaunchCooperativeKernel((const void*)fwd_mega, dim3(grid), dim3(NT), kargs, LDS_BYTES, stream);
    if (e != hipSuccess) fprintf(stderr, "kernel_launch: cooperative launch failed: %s (grid %d)\n", hipGetErrorString(e), grid);
}
```
